# Optimizing an MI355X kernel written in HIP

```python
import jax, jax.numpy as jnp
from jax import lax
import numpy as np

D_MODEL = 1024
BATCH = 16
SEQ = 2048
DEPTH = 2

GRID_W = 64
CTX_LEN = 256
D_MIX = D_MODEL
N_GROUPS_MIX = 4
GROUP_W = D_MIX // N_GROUPS_MIX
D_FF = 4 * D_MODEL
NORM_EPS = 1e-6
GN_EPS = 1e-5
CONV_K = 31
CONV_NORM_GROUPS = 4
RW_HEAD = 64
RW_HEADS = GROUP_W // RW_HEAD
RW_DECAY_LORA = 64
RW_A_LORA = 64
RW_GATE_LORA = 128
RW_LNX_EPS = 64e-5
POOL_WINDOWS = (2, 4, 8, 16)
POOL_CH = GROUP_W // len(POOL_WINDOWS)
MLA_HEADS = 4
MLA_NOPE = 64
MLA_ROPE = 32
MLA_V = 64
MLA_Q_RANK = 256
MLA_KV_RANK = 128
ROPE_BASE = 10000.0
Q_BLOCK = 128
N_CONV_IN = 2 * GROUP_W
N_POOL_IN = GROUP_W
N_Q_IN = MLA_Q_RANK
N_RW_IN = 3 * GROUP_W + RW_GATE_LORA + 2 * RW_DECAY_LORA + 2 * RW_A_LORA
N_KV_IN = MLA_KV_RANK + MLA_ROPE
OFF_POOL = N_CONV_IN
OFF_Q = OFF_POOL + N_POOL_IN
OFF_RW = OFF_Q + N_Q_IN
OFF_KV = OFF_RW + N_RW_IN
P_IN = OFF_KV + N_KV_IN
RW_R = 0
RW_K = GROUP_W
RW_V = 2 * GROUP_W
RW_G = 3 * GROUP_W
RW_W = RW_G + RW_GATE_LORA
RW_A = RW_W + 2 * RW_DECAY_LORA

kernel_name = "hybrid_parallel_mixer_prefix_dit"


def rms_norm(x, g, eps=NORM_EPS):
    xf = x.astype(jnp.float32)
    y = xf * lax.rsqrt(jnp.mean(xf * xf, axis=-1, keepdims=True) + eps)
    return (y * g.astype(jnp.float32)).astype(x.dtype)


def group_norm(x, n_groups, g, b, eps):
    shp = x.shape
    xf = x.astype(jnp.float32).reshape(*shp[:-1], n_groups, shp[-1] // n_groups)
    mu = jnp.mean(xf, axis=-1, keepdims=True)
    var = jnp.mean(jnp.square(xf - mu), axis=-1, keepdims=True)
    y = ((xf - mu) * lax.rsqrt(var + eps)).reshape(shp)
    return (y * g.astype(jnp.float32) + b.astype(jnp.float32)).astype(x.dtype)


def conv_module(p, dw, db, gn_g, gn_b, pw):
    u = p[..., :GROUP_W] * jax.nn.sigmoid(p[..., GROUP_W:])
    y = lax.conv_general_dilated(u, dw[:, None, :].astype(u.dtype), window_strides=(1,),
                                 padding=[(CONV_K // 2, CONV_K // 2)],
                                 dimension_numbers=("NWC", "WIO", "NWC"),
                                 feature_group_count=GROUP_W)
    y = jax.nn.silu(group_norm(y + db.astype(y.dtype), CONV_NORM_GROUPS, gn_g, gn_b, GN_EPS))
    return y @ pw.astype(y.dtype)


def multiscale_pool(p, pool_w, pool_scale):
    b, n, _ = p.shape
    u = p.astype(jnp.float32).reshape(b, n, len(POOL_WINDOWS), POOL_CH)
    cs = jnp.concatenate([jnp.zeros_like(u[:, :1]), jnp.cumsum(u, axis=1)], axis=1)
    t = jnp.arange(n)
    means = []
    for gi, w in enumerate(POOL_WINDOWS):
        lo = jnp.clip(t - w // 2, 0, n)
        hi = jnp.clip(t + w - w // 2, 0, n)
        cnt = (hi - lo).astype(jnp.float32)
        means.append((cs[:, hi, gi] - cs[:, lo, gi]) / cnt[None, :, None])
    d = jnp.stack(means, axis=2) - u
    y = jnp.einsum("bngc,gcd->bngd", d, pool_w.astype(jnp.float32)).reshape(b, n, GROUP_W)
    return (y * pool_scale.astype(jnp.float32)).astype(p.dtype)


def shift_mix(p, mu_prev, mu_next):
    prev = jnp.pad(p[:, :-1], ((0, 0), (1, 0), (0, 0)))
    nxt = jnp.pad(p[:, 1:], ((0, 0), (0, 1), (0, 0)))
    return p + mu_prev * (prev - p) + mu_next * (nxt - p)


def wkv7_scan(r, dec, k, v, kk, b):
    bsz, _, h, dh = r.shape
    xs = tuple(jnp.moveaxis(t, 1, 0) for t in (r, dec, k, v, kk, b))

    def step(S, inp):
        r_t, d_t, k_t, v_t, kk_t, b_t = inp
        sa = jnp.einsum("bhvk,bhk->bhv", S, kk_t)
        S = S * d_t[:, :, None, :] - sa[..., None] * b_t[:, :, None, :] + v_t[..., None] * k_t[:, :, None, :]
        return S, jnp.einsum("bhvk,bhk->bhv", S, r_t)

    _, ys = lax.scan(step, jnp.zeros((bsz, h, dh, dh), jnp.float32), xs)
    return jnp.moveaxis(ys, 0, 1)


def rwkv7_bidirectional(pl, pc, mu_prev, mu_next, w0, w2, a0, a2, g2, k_k, k_a, r_k, lnx_g, lnx_b, with_ctx):
    n_ctx = pc.shape[1]
    z = jnp.concatenate([shift_mix(pc, mu_prev, mu_next), shift_mix(pl, mu_prev, mu_next)],
                        axis=1).astype(jnp.float32)
    bsz, n, _ = z.shape

    def heads(t):
        return t.reshape(bsz, t.shape[1], RW_HEADS, RW_HEAD)

    def seg_flip(t):
        return jnp.concatenate([t[:, :n_ctx][:, ::-1], t[:, n_ctx:][:, ::-1]], axis=1)

    r = heads(z[..., RW_R:RW_K])
    k = z[..., RW_K:RW_V]
    v = heads(z[..., RW_V:RW_G])
    kk = heads(k * k_k)
    kk = kk / jnp.maximum(jnp.sqrt(jnp.sum(kk * kk, axis=-1, keepdims=True)), 1e-12)
    sel = slice(0, n) if with_ctx else slice(n_ctx, n)
    wkv, bonus = [], []
    for d in range(2):
        wl = z[..., RW_W + d * RW_DECAY_LORA: RW_W + (d + 1) * RW_DECAY_LORA]
        al = z[..., RW_A + d * RW_A_LORA: RW_A + (d + 1) * RW_A_LORA]
        log_w = -jax.nn.softplus(-(w0[d] + jnp.tanh(wl) @ w2[d])) - 0.5
        dec = heads(jnp.exp(-jnp.exp(log_w)))
        a = jax.nn.sigmoid(a0[d] + al @ a2[d])
        kd = heads(k * (1.0 + (a - 1.0) * k_a))
        ins = (r, dec, kd, v, kk, kk * heads(a))
        if d == 0:
            wkv.append(wkv7_scan(*ins))
        else:
            wkv.append(seg_flip(wkv7_scan(*[seg_flip(t) for t in ins])))
        bonus.append(jnp.sum(r[:, sel] * kd[:, sel] * r_k, axis=-1, keepdims=True) * v[:, sel])
    o = group_norm((wkv[0] + wkv[1])[:, sel].reshape(bsz, -1, GROUP_W), RW_HEADS, lnx_g, lnx_b, RW_LNX_EPS)
    gate = jax.nn.sigmoid(z[:, sel, RW_G:RW_W]) @ g2
    o = ((o + (bonus[0] + bonus[1]).reshape(bsz, -1, GROUP_W)) * gate).astype(pl.dtype)
    if with_ctx:
        return o[:, n_ctx:], o[:, :n_ctx]
    return o, None


def axial_angles(n):
    rows = n // GRID_W
    row = jnp.repeat(jnp.arange(rows), GRID_W).astype(jnp.float32)
    col = jnp.tile(jnp.arange(GRID_W), rows).astype(jnp.float32)
    n_freq = MLA_ROPE // 4
    freq = ROPE_BASE ** (-jnp.arange(n_freq, dtype=jnp.float32) / n_freq)
    return jnp.stack([row[:, None] * freq, col[:, None] * freq], axis=1)


def rope_2d(x, ang):
    xs = x.astype(jnp.float32).reshape(*x.shape[:-1], 2, 2, MLA_ROPE // 4)
    x1, x2 = xs[..., 0, :], xs[..., 1, :]
    cos, sin = jnp.cos(ang), jnp.sin(ang)
    y = jnp.stack([x1 * cos - x2 * sin, x1 * sin + x2 * cos], axis=-2)
    return y.reshape(x.shape).astype(x.dtype)


def mla_keys_values(pkv, kvn_g, wukv, ang):
    b, n, _ = pkv.shape
    c_kv = rms_norm(pkv[..., :MLA_KV_RANK], kvn_g)
    kv = (c_kv @ wukv.astype(c_kv.dtype)).reshape(b, n, MLA_HEADS, MLA_NOPE + MLA_V)
    k_rope = pkv[..., MLA_KV_RANK:]
    if ang is not None:
        k_rope = rope_2d(k_rope, ang)
    k = jnp.concatenate([kv[..., :MLA_NOPE],
                         jnp.broadcast_to(k_rope[:, :, None, :], (b, n, MLA_HEADS, MLA_ROPE))], axis=-1)
    return k, kv[..., MLA_NOPE:]


def mla_queries(pq, qn_g, wuq, ang):
    b, n, _ = pq.shape
    q = (rms_norm(pq, qn_g) @ wuq.astype(pq.dtype)).reshape(b, n, MLA_HEADS, MLA_NOPE + MLA_ROPE)
    q_rope = q[..., MLA_NOPE:]
    if ang is not None:
        q_rope = rope_2d(q_rope, ang[:, None])
    return jnp.concatenate([q[..., :MLA_NOPE], q_rope], axis=-1)


def block_attention(q, k, v):
    b, n, h, dq = q.shape
    nb = n // Q_BLOCK
    qb = jnp.moveaxis(q.reshape(b, nb, Q_BLOCK, h, dq), 1, 0)
    scale = dq ** -0.5

    def one_block(qi):
        s = jnp.einsum("bqhd,bkhd->bhqk", qi, k).astype(jnp.float32) * scale
        pr = jax.nn.softmax(s, axis=-1).astype(v.dtype)
        return jnp.einsum("bhqk,bkhd->bqhd", pr, v)

    o = lax.map(one_block, qb)
    return jnp.moveaxis(o, 0, 1).reshape(b, n, h * v.shape[-1])


def sq_relu_mlp(h, w1, w2):
    return jnp.square(jax.nn.relu(h @ w1)) @ w2


def setup_inputs(seed: int = 0) -> dict:
    key = jax.random.key(seed)
    ks = iter(jax.random.split(key, 40))

    def nrm(shape, s):
        return jax.random.normal(next(ks), shape, jnp.float32) * s

    def gain(shape):
        return 1.0 + nrm(shape, 0.1)

    L, D, G = DEPTH, D_MODEL, GROUP_W
    return {
        "x": nrm((BATCH, SEQ, D), 1.0),
        "c": nrm((BATCH, D), 1.0),
        "ctx": nrm((BATCH, CTX_LEN, D), 1.0),
        "c_ctx": nrm((D,), 1.0),
        "ada_w": nrm((L, D, 6 * D), D ** -0.5),
        "ada_b": nrm((L, 6 * D), 0.02),
        "norm1_g": gain((L, D)),
        "norm2_g": gain((L, D)),
        "w_in": nrm((L, D, P_IN), D ** -0.5),
        "w_out": nrm((L, D_MIX, D), D_MIX ** -0.5),
        "conv_dw": nrm((L, CONV_K, G), CONV_K ** -0.5),
        "conv_db": nrm((L, G), 0.01),
        "conv_gn_g": gain((L, G)),
        "conv_gn_b": nrm((L, G), 0.01),
        "conv_pw": nrm((L, G, G), G ** -0.5),
        "pool_w": nrm((L, len(POOL_WINDOWS), POOL_CH, POOL_CH), POOL_CH ** -0.5),
        "pool_scale": gain((L, G)),
        "rw_mu_prev": jax.random.uniform(next(ks), (L, N_RW_IN), jnp.float32, 0.0, 0.5),
        "rw_mu_next": jax.random.uniform(next(ks), (L, N_RW_IN), jnp.float32, 0.0, 0.5),
        "rw_w0": nrm((L, 2, G), 0.5),
        "rw_w2": nrm((L, 2, RW_DECAY_LORA, G), 0.5 * RW_DECAY_LORA ** -0.5),
        "rw_a0": nrm((L, 2, G), 0.1),
        "rw_a2": nrm((L, 2, RW_A_LORA, G), 0.5 * RW_A_LORA ** -0.5),
        "rw_g2": nrm((L, RW_GATE_LORA, G), RW_GATE_LORA ** -0.5),
        "rw_kk": gain((L, G)),
        "rw_ka": gain((L, G)),
        "rw_rk": nrm((L, RW_HEADS, RW_HEAD), 0.1),
        "rw_lnx_g": gain((L, G)),
        "rw_lnx_b": nrm((L, G), 0.01),
        "mla_qn_g": gain((L, MLA_Q_RANK)),
        "mla_wuq": nrm((L, MLA_Q_RANK, MLA_HEADS * (MLA_NOPE + MLA_ROPE)), MLA_Q_RANK ** -0.5),
        "mla_kvn_g": gain((L, MLA_KV_RANK)),
        "mla_wukv": nrm((L, MLA_KV_RANK, MLA_HEADS * (MLA_NOPE + MLA_V)), MLA_KV_RANK ** -0.5),
        "mlp_w1": nrm((L, D, D_FF), D ** -0.5),
        "mlp_w2": nrm((L, D_FF, D), D_FF ** -0.5),
        "final_g": gain((D,)),
    }


def reference(x, c, ctx, c_ctx, ada_w, ada_b, norm1_g, norm2_g, w_in, w_out, conv_dw, conv_db, conv_gn_g,
              conv_gn_b, conv_pw, pool_w, pool_scale, rw_mu_prev, rw_mu_next, rw_w0, rw_w2, rw_a0, rw_a2,
              rw_g2, rw_kk, rw_ka, rw_rk, rw_lnx_g, rw_lnx_b, mla_qn_g, mla_wuq, mla_kvn_g, mla_wukv,
              mlp_w1, mlp_w2, final_g):
    ang = axial_angles(x.shape[1])
    xc = ctx
    s_lat = jax.nn.silu(c)
    s_ctx = jax.nn.silu(c_ctx)
    for l in range(DEPTH):
        with_ctx = l < DEPTH - 1
        mod = jnp.split((s_lat @ ada_w[l] + ada_b[l])[:, None, :], 6, axis=-1)
        modc = jnp.split(s_ctx @ ada_w[l] + ada_b[l], 6, axis=-1)
        h = rms_norm(x, norm1_g[l]) * (1.0 + mod[1]) + mod[0]
        hc = rms_norm(xc, norm1_g[l]) * (1.0 + modc[1]) + modc[0]
        p = h @ w_in[l]
        pc_tail = hc @ w_in[l][:, OFF_RW:]

        y_conv = conv_module(p[..., :OFF_POOL], conv_dw[l], conv_db[l], conv_gn_g[l], conv_gn_b[l], conv_pw[l])
        y_pool = multiscale_pool(p[..., OFF_POOL:OFF_Q], pool_w[l], pool_scale[l])
        y_rw, yc_rw = rwkv7_bidirectional(p[..., OFF_RW:OFF_KV], pc_tail[..., :N_RW_IN], rw_mu_prev[l],
                                          rw_mu_next[l], rw_w0[l], rw_w2[l], rw_a0[l], rw_a2[l], rw_g2[l],
                                          rw_kk[l], rw_ka[l], rw_rk[l], rw_lnx_g[l], rw_lnx_b[l], with_ctx)
        k_l, v_l = mla_keys_values(p[..., OFF_KV:], mla_kvn_g[l], mla_wukv[l], ang)
        k_c, v_c = mla_keys_values(pc_tail[..., N_RW_IN:], mla_kvn_g[l], mla_wukv[l], None)
        q_l = mla_queries(p[..., OFF_Q:OFF_RW], mla_qn_g[l], mla_wuq[l], ang)
        y_att = block_attention(q_l, jnp.concatenate([k_c, k_l], axis=1), jnp.concatenate([v_c, v_l], axis=1))

        x = x + mod[2] * (jnp.concatenate([y_conv, y_rw, y_pool, y_att], axis=-1) @ w_out[l])
        x = x + mod[5] * sq_relu_mlp(rms_norm(x, norm2_g[l]) * (1.0 + mod[4]) + mod[3], mlp_w1[l], mlp_w2[l])

        if with_ctx:
            pc_head = hc @ w_in[l][:, :OFF_RW]
            yc_conv = conv_module(pc_head[..., :OFF_POOL], conv_dw[l], conv_db[l], conv_gn_g[l], conv_gn_b[l],
                                  conv_pw[l])
            yc_pool = multiscale_pool(pc_head[..., OFF_POOL:OFF_Q], pool_w[l], pool_scale[l])
            q_c = mla_queries(pc_head[..., OFF_Q:OFF_RW], mla_qn_g[l], mla_wuq[l], None)
            yc_att = block_attention(q_c, k_c, v_c)
            xc = xc + modc[2] * (jnp.concatenate([yc_conv, yc_rw, yc_pool, yc_att], axis=-1) @ w_out[l])
            xc = xc + modc[5] * sq_relu_mlp(rms_norm(xc, norm2_g[l]) * (1.0 + modc[4]) + modc[3],
                                            mlp_w1[l], mlp_w2[l])
    return rms_norm(x, final_g)
```

```cpp
#include <hip/hip_runtime.h>
#include <hip/hip_cooperative_groups.h>
#include <cstdio>
namespace cg = cooperative_groups;

#define DI __device__ __forceinline__
typedef unsigned short u16;
typedef __attribute__((ext_vector_type(8))) short bf16x8;
typedef __attribute__((ext_vector_type(16))) float f32x16;
typedef __attribute__((ext_vector_type(4))) unsigned u32x4;
typedef __attribute__((ext_vector_type(2))) unsigned u32x2;
typedef float f2 __attribute__((ext_vector_type(2)));
#define MFMA(a, b, c) __builtin_amdgcn_mfma_f32_32x32x16_bf16((a), (b), (c), 0, 0, 0)

constexpr int NB = 16, TL = 2048, CL = 256, NP = 2304, NTOK = NB * NP, DM = 1024;
constexpr int PIN = 2336, PINP = 2432, DFF = 4096;
constexpr int OFF_POOL = 512, OFF_Q = 768, OFF_RW = 1024, OFF_KV = 2176;

constexpr size_t WT_WIN = 0;
constexpr size_t WT_WOUT = WT_WIN + (size_t)PINP * 1024;
constexpr size_t WT_W1 = WT_WOUT + 1024 * 1024;
constexpr size_t WT_W2 = WT_W1 + 4096 * 1024;
constexpr size_t WT_PW = WT_W2 + 4096 * 1024;
constexpr size_t WT_WUQ = WT_PW + 256 * 256;
constexpr size_t WT_WUKV = WT_WUQ + 384 * 256;
constexpr size_t WT_POOL = WT_WUKV + 512 * 128;
constexpr size_t WT_RW2 = WT_POOL + 4 * 64 * 64;
constexpr size_t WT_RA2 = WT_RW2 + 2 * 256 * 64;
constexpr size_t WT_RG2 = WT_RA2 + 2 * 256 * 64;
constexpr size_t WT_END = WT_RG2 + 256 * 128;
constexpr size_t WS_WT = 0;
constexpr size_t WS_MOD = WS_WT + WT_END * 2;
constexpr size_t WS_XCTX = WS_MOD + (size_t)2 * 17 * 6144 * 4;
constexpr size_t WS_BONUS = WS_XCTX + (size_t)NB * CL * DM * 4;
constexpr size_t WS_CNT = WS_BONUS + (size_t)2 * NTOK * 4 * 4;
constexpr size_t WS_TAB = WS_CNT + 256;
constexpr size_t WS_BAR = WS_TAB + 512;
constexpr size_t WS_H = WS_BAR + 3456 * 4;
constexpr size_t WS_BIG = WS_H + (size_t)NTOK * DM * 2;
constexpr size_t SZ_TOK256 = (size_t)NTOK * 256 * 2;
constexpr size_t BIG_P = 0;
constexpr size_t BIG_Q = BIG_P + (size_t)NTOK * PIN * 2;
constexpr size_t BIG_KN = BIG_Q + (size_t)NTOK * 384 * 2;
constexpr size_t BIG_KR = BIG_KN + SZ_TOK256;
constexpr size_t BIG_VT = BIG_KR + (size_t)NTOK * 32 * 2;
constexpr size_t BIG_SR = BIG_VT + SZ_TOK256;
constexpr size_t BIG_SKK = BIG_SR + SZ_TOK256;
constexpr size_t BIG_SV = BIG_SKK + SZ_TOK256;
constexpr size_t BIG_SDEC = BIG_SV + SZ_TOK256;
constexpr size_t BIG_SKD = BIG_SDEC + 2 * SZ_TOK256;
constexpr size_t BIG_SB = BIG_SKD + 2 * SZ_TOK256;
constexpr size_t BIG_END = BIG_SB + 2 * SZ_TOK256;
DI float* yrow(char* ws, size_t g, int d) { return (float*)(ws + WS_BIG + BIG_P + g * (size_t)(PIN * 2) + OFF_RW * 2 + d * 1024); }
constexpr size_t WS_TOTAL = WS_BIG + BIG_END;
static_assert((size_t)NTOK * DFF * 2 <= BIG_END, "Hff must fit");

constexpr int SMEM_BYTES = 59392;
#ifndef PROBE
#define PROBE 0
#endif

struct Params {
  const float* in[36];
  float* out;
  char* ws;
  int wave64;
  int pad_;
};

DI u16 f2bf(float x) {
  unsigned u = __float_as_uint(x);
  u += 0x7fffu + ((u >> 16) & 1u);
  return (u16)(u >> 16);
}
DI int lane_id_() { unsigned z = 0u; asm volatile("" : "+v"(z)); return (int)__builtin_amdgcn_mbcnt_hi(~0u, __builtin_amdgcn_mbcnt_lo(~0u, z)); }
#define TIDX (p.wave64 + lane_id_())
DI int opaque(int x) { asm volatile("" : "+v"(x)); return x; }
struct PW { char* ws; float* out; int wave64; };
DI char* opaque_p(char* x) { asm volatile("" : "+s"(x)); return x; }
DI int opaque_s(int x) { asm volatile("" : "+s"(x)); return x; }
DI float bf2f(u16 v) { return __uint_as_float(((unsigned)v) << 16); }
DI unsigned pack2(float a, float b) { return (unsigned)f2bf(a) | ((unsigned)f2bf(b) << 16); }
DI float bflo(unsigned u) { return __uint_as_float(u << 16); }
DI float bfhi(unsigned u) { return __uint_as_float(u & 0xffff0000u); }
DI float sigm(float x) { return 1.f / (1.f + __expf(-x)); }
DI int crow(int i, int h) { return (i & 3) + 8 * (i >> 2) + 4 * h; }
DI float dpp_f(float v, int ctrl_sel) {
  int x = __float_as_int(v);
  int r;
  if (ctrl_sel == 0) r = __builtin_amdgcn_update_dpp(0, x, 0xB1, 0xf, 0xf, true);
  else if (ctrl_sel == 1) r = __builtin_amdgcn_update_dpp(0, x, 0x4E, 0xf, 0xf, true);
  else r = __builtin_amdgcn_update_dpp(0, x, 0x141, 0xf, 0xf, true);
  return __int_as_float(r);
}
DI float sum8(float v) {
  v += dpp_f(v, 0);
  v += dpp_f(v, 1);
  v += dpp_f(v, 2);
  return v;
}

DI float wsum(float v) {
  v += dpp_f(v, 0);
  v += dpp_f(v, 1);
  v += dpp_f(v, 2);
  v += __int_as_float(__builtin_amdgcn_update_dpp(0, __float_as_int(v), 0x140, 0xf, 0xf, true));
  int x = __float_as_int(v);
  return (__int_as_float(__builtin_amdgcn_readlane(x, 0)) + __int_as_float(__builtin_amdgcn_readlane(x, 16))) +
         (__int_as_float(__builtin_amdgcn_readlane(x, 32)) + __int_as_float(__builtin_amdgcn_readlane(x, 48)));
}

DI const float* inp(const char* ws, int i) {
  unsigned long long v = ((const unsigned long long*)(ws + WS_TAB))[i];
  unsigned lo = __builtin_amdgcn_readfirstlane((unsigned)v), hi = __builtin_amdgcn_readfirstlane((unsigned)(v >> 32));
  return (const float*)(((unsigned long long)hi << 32) | (unsigned long long)lo);
}
#define IN(i) inp(p.ws, (i))
template <class PT>
DI const float* xsrc_row(const PT& p, bool from_input, int g) {
  int b = g / NP, pos = g - b * NP;
  if (pos < CL) return (from_input ? IN(2) : (const float*)(p.ws + WS_XCTX)) + ((size_t)(b * CL + pos)) * DM;
  return (from_input ? IN(0) : (const float*)p.out) + ((size_t)(b * TL + pos - CL)) * DM;
}
template <class PT>
DI float* xdst_row(const PT& p, int g) {
  int b = g / NP, pos = g - b * NP;
  if (pos < CL) return (float*)(p.ws + WS_XCTX) + ((size_t)(b * CL + pos)) * DM;
  return p.out + ((size_t)(b * TL + pos - CL)) * DM;
}

template <bool DIRECT>
DI void wdesc(const Params& p, int l, int i, const float*& src, u16*& dst, int& K, int& N, int& Npad) {
#define WIN(k) (DIRECT ? p.in[k] : IN(k))
  u16* wt = (u16*)(p.ws + WS_WT);
  if (i == 0) { src = WIN(8) + (size_t)l * 1024 * PIN; dst = wt + WT_WIN; K = 1024; N = PIN; Npad = PINP; }
  else if (i == 1) { src = WIN(9) + (size_t)l * 1024 * 1024; dst = wt + WT_WOUT; K = 1024; N = 1024; Npad = 1024; }
  else if (i == 2) { src = WIN(33) + (size_t)l * 1024 * 4096; dst = wt + WT_W1; K = 1024; N = 4096; Npad = 4096; }
  else if (i == 3) { src = WIN(34) + (size_t)l * 4096 * 1024; dst = wt + WT_W2; K = 4096; N = 1024; Npad = 1024; }
  else if (i == 4) { src = WIN(14) + (size_t)l * 65536; dst = wt + WT_PW; K = 256; N = 256; Npad = 256; }
  else if (i == 5) { src = WIN(30) + (size_t)l * 256 * 384; dst = wt + WT_WUQ; K = 256; N = 384; Npad = 384; }
  else if (i == 6) { src = WIN(32) + (size_t)l * 128 * 512; dst = wt + WT_WUKV; K = 128; N = 512; Npad = 512; }
  else if (i < 11) { src = WIN(15) + (size_t)l * 16384 + (i - 7) * 4096; dst = wt + WT_POOL + (i - 7) * 4096; K = 64; N = 64; Npad = 64; }
  else if (i < 13) { src = WIN(20) + (size_t)l * 32768 + (i - 11) * 16384; dst = wt + WT_RW2 + (i - 11) * 16384; K = 64; N = 256; Npad = 256; }
  else if (i < 15) { src = WIN(22) + (size_t)l * 32768 + (i - 13) * 16384; dst = wt + WT_RA2 + (i - 13) * 16384; K = 64; N = 256; Npad = 256; }
  else { src = WIN(23) + (size_t)l * 32768; dst = wt + WT_RG2; K = 128; N = 256; Npad = 256; }
}
#undef WIN

DI void convert_tile(const float* __restrict__ src, u16* __restrict__ dst, int K, int N, int k0, int n0, char* smem, int tid_in) {
  float* tile = (float*)smem;
  const int tid = opaque(tid_in);
  __syncthreads();
#pragma unroll
  for (int i = 0; i < 16; ++i) {
    int e = tid + 256 * i, kk = e >> 6, nn = e & 63;
    float v = 0.f;
    if (n0 + nn < N) v = src[(size_t)(k0 + kk) * N + n0 + nn];
    tile[kk * 65 + nn] = v;
  }
  __syncthreads();
#pragma unroll
  for (int i = 0; i < 8; ++i) {
    int e = tid + 256 * i, nn = e >> 5, kp = e & 31;
    unsigned v = pack2(tile[(2 * kp) * 65 + nn], tile[(2 * kp + 1) * 65 + nn]);
    *(unsigned*)(dst + (size_t)(n0 + nn) * K + k0 + 2 * kp) = v;
  }
}

constexpr int N_CONV_TILES = 2996;
template <bool DIRECT>
DI void convert_item(const Params& p, int l, int item, char* smem) {
  int acc = 0;
  for (int i = 0; i < 16; ++i) {
    const float* src; u16* dst; int K, N, Npad;
    wdesc<DIRECT>(p, l, i, src, dst, K, N, Npad);
    int tn = Npad >> 6, cnt = (K >> 6) * tn;
    if (item < acc + cnt) {
      int t = item - acc;
      convert_tile(src, dst, K, N, (t / tn) * 64, (t % tn) * 64, smem, TIDX);
      return;
    }
    acc += cnt;
  }
}

DI void mod_item(const Params& p, int item, char* smem) {
  const int l = item / 96, cb = item % 96;
  const int tid = opaque(TIDX), cq = tid & 15, kg = tid >> 4, lane = tid & 63, wave = tid >> 6;
  float* sl = (float*)smem;
  float* red = (float*)(smem + 34816);
  const float* W = p.in[4] + (size_t)l * 1024 * 6144;
  const int col = cb * 64 + cq * 4;
  float acc[17][4];
#pragma unroll
  for (int b = 0; b < 17; ++b) { acc[b][0] = acc[b][1] = acc[b][2] = acc[b][3] = 0.f; }
  for (int half = 0; half < 2; ++half) {
    __syncthreads();
    for (int e = tid; e < 17 * 512; e += 256) {
      int b = e >> 9, k = e & 511;
      float cv = (b < 16) ? p.in[1][b * 1024 + half * 512 + k] : p.in[3][half * 512 + k];
      sl[e] = cv * sigm(cv);
    }
    __syncthreads();
#pragma unroll 8
    for (int kk = 0; kk < 32; ++kk) {
      int kl = kg * 32 + kk;
      float4 w = *(const float4*)(W + (size_t)(half * 512 + kl) * 6144 + col);
#pragma unroll
      for (int b = 0; b < 17; ++b) {
        float s = sl[b * 512 + kl];
        acc[b][0] += s * w.x; acc[b][1] += s * w.y; acc[b][2] += s * w.z; acc[b][3] += s * w.w;
      }
    }
  }
#pragma unroll
  for (int b = 0; b < 17; ++b)
#pragma unroll
    for (int j = 0; j < 4; ++j) {
      float v = acc[b][j];
      v += __shfl_xor(v, 16, 64);
      v += __shfl_xor(v, 32, 64);
      acc[b][j] = v;
    }
  __syncthreads();
  if (lane < 16) {
#pragma unroll
    for (int b = 0; b < 17; ++b)
#pragma unroll
      for (int j = 0; j < 4; ++j) red[(wave * 17 + b) * 64 + cq * 4 + j] = acc[b][j];
  }
  __syncthreads();
  float* mod = (float*)(p.ws + WS_MOD) + (size_t)l * 17 * 6144;
  for (int e = tid; e < 17 * 64; e += 256) {
    int b = e >> 6, cc = e & 63;
    float v = red[(0 * 17 + b) * 64 + cc] + red[(1 * 17 + b) * 64 + cc] + red[(2 * 17 + b) * 64 + cc] + red[(3 * 17 + b) * 64 + cc];
    mod[b * 6144 + cb * 64 + cc] = v + p.in[5][l * 6144 + cb * 64 + cc];
  }
}

DI void norm_phase(const Params& p, int l, const float* gw, int isft, int isc, bool from_input, bool skip_ctx) {
  const int lane = TIDX & 63, wave = TIDX >> 6;
  const int gwv = blockIdx.x * 4 + wave, nw = gridDim.x * 4;
  u16* H = (u16*)(p.ws + WS_H);
  const float* mod = (const float*)(p.ws + WS_MOD) + (size_t)l * 17 * 6144;
  const int first = skip_ctx ? CL : 0, per_b = NP - first, total = NB * per_b;
  constexpr int RB = 4;
  for (int base = gwv; base < total; base += nw * RB) {
    float4 v[RB][4];
    int gi[RB];
#pragma unroll
    for (int k = 0; k < RB; ++k) {
      int idx = min(base + k * nw, total - 1);
      int b = idx / per_b, pos = first + (idx - b * per_b);
      gi[k] = b * NP + pos;
      const float* x = xsrc_row(p, from_input, gi[k]);
#pragma unroll
      for (int i = 0; i < 4; ++i) v[k][i] = *(const float4*)(x + lane * 4 + 256 * i);
    }
#pragma unroll
    for (int k = 0; k < RB; ++k) {
      if (base + k * nw >= total) break;
      const int g = gi[k];
      const int b = g / NP, pos = g - b * NP;
      const float* mrow = mod + (size_t)(pos < CL ? 16 : b) * 6144;
      float ss = 0.f;
#pragma unroll
      for (int i = 0; i < 4; ++i) ss += v[k][i].x * v[k][i].x + v[k][i].y * v[k][i].y + v[k][i].z * v[k][i].z + v[k][i].w * v[k][i].w;
      ss = wsum(ss);
      float rs = rsqrtf(ss * (1.f / 1024.f) + 1e-6f);
#pragma unroll
      for (int i = 0; i < 4; ++i) {
        int c = lane * 4 + 256 * i;
        float4 gg = *(const float4*)(gw + c);
        float4 sc = *(const float4*)(mrow + isc * 1024 + c);
        float4 sf = *(const float4*)(mrow + isft * 1024 + c);
        float a0 = v[k][i].x * rs * gg.x * (1.f + sc.x) + sf.x;
        float a1 = v[k][i].y * rs * gg.y * (1.f + sc.y) + sf.y;
        float a2 = v[k][i].z * rs * gg.z * (1.f + sc.z) + sf.z;
        float a3 = v[k][i].w * rs * gg.w * (1.f + sc.w) + sf.w;
        u32x2 o; o[0] = pack2(a0, a1); o[1] = pack2(a2, a3);
        *(u32x2*)(H + (size_t)g * DM + c) = o;
      }
    }
  }
}

DI void final_norm_phase(const Params& p) {
  const int lane = TIDX & 63, wave = TIDX >> 6;
  const int gwv = blockIdx.x * 4 + wave, nw = gridDim.x * 4;
  const float* gw = IN(35);
  constexpr int RB = 4;
  const int total = NB * TL;
  for (int base = gwv; base < total; base += nw * RB) {
    float4 v[RB][4];
#pragma unroll
    for (int k = 0; k < RB; ++k) {
      int row = min(base + k * nw, total - 1);
      const float* x = p.out + (size_t)row * DM;
#pragma unroll
      for (int i = 0; i < 4; ++i) v[k][i] = *(const float4*)(x + lane * 4 + 256 * i);
    }
#pragma unroll
    for (int k = 0; k < RB; ++k) {
      int row = base + k * nw;
      if (row >= total) break;
      float* x = p.out + (size_t)row * DM;
      float ss = 0.f;
#pragma unroll
      for (int i = 0; i < 4; ++i) ss += v[k][i].x * v[k][i].x + v[k][i].y * v[k][i].y + v[k][i].z * v[k][i].z + v[k][i].w * v[k][i].w;
      ss = wsum(ss);
      float rs = rsqrtf(ss * (1.f / 1024.f) + 1e-6f);
#pragma unroll
      for (int i = 0; i < 4; ++i) {
        int c = lane * 4 + 256 * i;
        float4 gg = *(const float4*)(gw + c);
        float4 o;
        o.x = v[k][i].x * rs * gg.x; o.y = v[k][i].y * rs * gg.y; o.z = v[k][i].z * rs * gg.z; o.w = v[k][i].w * rs * gg.w;
        *(float4*)(x + c) = o;
      }
    }
  }
}

template <int MT, int EPI, int NTW = 2>
DI void gemm_tile(const Params& pp, const u16* __restrict__ A, int lda, const u16* __restrict__ Bt, int K,
                          int m0, int n0, char* smem, int l, int modidx, bool from_input) {
  const PW p = {opaque_p(pp.ws), pp.out, pp.wave64};
  constexpr int BM = 64 * MT;
  constexpr int LS = 72;
  constexpr int NR = (MT == 2) ? 2 : 1;
  u16* As = (u16*)smem;
  u16* Bs = As + BM * LS;
  const int tid = opaque(TIDX), lane = tid & 63, wave = tid >> 6;
  const int wm = wave >> 1, wn = wave & 1, r = lane & 31, h = lane >> 5;
  f32x16 acc[MT][NTW];
#pragma unroll
  for (int a = 0; a < MT; ++a)
#pragma unroll
    for (int b = 0; b < NTW; ++b)
#pragma unroll
      for (int i = 0; i < 16; ++i) acc[a][b][i] = 0.f;
  u32x4 ra[NR][2 * MT], rb[NR][2 * NTW];
  const int nk = K >> 6;
  const int lrow = tid >> 3, lkc = tid & 7;
  const char* Abase = (const char*)(A + (size_t)m0 * lda);
  const char* Bbase = (const char*)(Bt + (size_t)n0 * K);
  const unsigned voffA = (unsigned)(lrow * lda + lkc * 8) * 2u;
  const unsigned voffB = (unsigned)(lrow * K + lkc * 8) * 2u;
  const unsigned lds_w = (unsigned)(lrow * LS + lkc * 8);
#define GL(set, kt_)                                                                                      \
  {                                                                                                       \
    _Pragma("unroll") for (int i = 0; i < 2 * MT; ++i)                                                    \
        ra[set][i] = *(const u32x4*)(Abase + ((size_t)(32 * i) * lda + (size_t)(kt_) * 64) * 2 + voffA);  \
    _Pragma("unroll") for (int i = 0; i < 2 * NTW; ++i)                                                   \
        rb[set][i] = *(const u32x4*)(Bbase + ((size_t)(32 * i) * K + (size_t)(kt_) * 64) * 2 + voffB);    \
  }
  if (MT == 2) {
    GL(0, 0)
    if (nk > 1) GL(1, 1)
    __syncthreads();
#pragma unroll
    for (int i = 0; i < 2 * MT; ++i) *(u32x4*)(As + lds_w + 32 * i * LS) = ra[0][i];
#pragma unroll
    for (int i = 0; i < 2 * NTW; ++i) *(u32x4*)(Bs + lds_w + 32 * i * LS) = rb[0][i];
    if (nk > 2) GL(0, 2)
    __syncthreads();
    for (int kt = 0; kt < nk; kt += 2) {
#pragma unroll
      for (int s = 0; s < 2; ++s) {
        bf16x8 af[4][MT], bfr[4][NTW];
#pragma unroll
        for (int ks = 0; ks < 4; ++ks) {
#pragma unroll
          for (int a = 0; a < MT; ++a) af[ks][a] = *(const bf16x8*)(As + (wm * 32 * MT + a * 32 + r) * LS + ks * 16 + h * 8);
#pragma unroll
          for (int b = 0; b < NTW; ++b) bfr[ks][b] = *(const bf16x8*)(Bs + (wn * 32 * NTW + b * 32 + r) * LS + ks * 16 + h * 8);
        }
        __syncthreads();
        if (kt + s + 1 < nk) {
#pragma unroll
          for (int i = 0; i < 2 * MT; ++i) *(u32x4*)(As + lds_w + 32 * i * LS) = ra[(s + 1) & 1][i];
#pragma unroll
          for (int i = 0; i < 2 * NTW; ++i) *(u32x4*)(Bs + lds_w + 32 * i * LS) = rb[(s + 1) & 1][i];
          if (kt + s + 3 < nk) GL((s + 1) & 1, kt + s + 3)
        }
#pragma unroll
        for (int ks = 0; ks < 4; ++ks)
#pragma unroll
          for (int a = 0; a < MT; ++a)
#pragma unroll
            for (int b = 0; b < NTW; ++b) acc[a][b] = MFMA(af[ks][a], bfr[ks][b], acc[a][b]);
        __syncthreads();
      }
    }
  } else {
#pragma unroll
  for (int s = 0; s < NR; ++s) GL(s, s)
  for (int kt = 0; kt < nk; kt += NR) {

#pragma unroll
    for (int s = 0; s < NR; ++s) {
      __syncthreads();
#pragma unroll
      for (int i = 0; i < 2 * MT; ++i) *(u32x4*)(As + lds_w + 32 * i * LS) = ra[s][i];
#pragma unroll
      for (int i = 0; i < 2 * NTW; ++i) *(u32x4*)(Bs + lds_w + 32 * i * LS) = rb[s][i];
      __syncthreads();
      if (kt + s + NR < nk) GL(s, kt + s + NR)
#pragma unroll
      for (int ks = 0; ks < 4; ++ks) {
        bf16x8 af[MT], bfr[NTW];
#pragma unroll
        for (int a = 0; a < MT; ++a) af[a] = *(const bf16x8*)(As + (wm * 32 * MT + a * 32 + r) * LS + ks * 16 + h * 8);
#pragma unroll
        for (int b = 0; b < NTW; ++b) bfr[b] = *(const bf16x8*)(Bs + (wn * 32 * NTW + b * 32 + r) * LS + ks * 16 + h * 8);
#pragma unroll
        for (int a = 0; a < MT; ++a)
#pragma unroll
          for (int b = 0; b < NTW; ++b) acc[a][b] = MFMA(af[a], bfr[b], acc[a][b]);
      }
    }
  }
  }
#undef GL
  if (EPI == 0 || EPI == 2) {
    constexpr int CS = 136;
    constexpr int NPASS = MT / 2;
    u16* Cs = (u16*)smem;
    u16* Cg = (EPI == 0) ? (u16*)(p.ws + WS_BIG + BIG_P) : (u16*)(p.ws + WS_BIG);
    const int ldc = (EPI == 0) ? PIN : DFF;
#pragma unroll
    for (int pass = 0; pass < NPASS; ++pass) {
      __syncthreads();
      if (NPASS == 1 || wm == pass) {
#pragma unroll
        for (int a = 0; a < MT; ++a)
#pragma unroll
          for (int b = 0; b < NTW; ++b) {
            u16* cp = Cs + ((NPASS == 1 ? wm * 64 : 0) + a * 32 + 4 * h) * CS + wn * 32 * NTW + b * 32 + r;
#pragma unroll
            for (int i = 0; i < 16; ++i) {
              float v = acc[a][b][i];
              if (EPI == 2) { v = fmaxf(v, 0.f); v = v * v; }
              cp[(8 * (i >> 2) + (i & 3)) * CS] = f2bf(v);
            }
          }
      }
      __syncthreads();
#pragma unroll
      for (int i = 0; i < 8; ++i) {
        int e = tid + 256 * i, row = e >> 4, cc = e & 15;
        if (EPI == 2 || n0 + cc * 8 < PIN) {
          u32x4 v = *(const u32x4*)(Cs + row * CS + cc * 8);
          *(u32x4*)(Cg + (size_t)(m0 + pass * 128 + row) * ldc + n0 + cc * 8) = v;
        }
      }
    }
  } else if (EPI == 1) {
    const int bb = m0 / NP, pos0 = m0 - bb * NP;
    const float* src = xsrc_row(p, from_input, m0);
    float* dst = xdst_row(p, m0);
    const float* mrow = (const float*)(p.ws + WS_MOD) + (size_t)l * 17 * 6144 + (size_t)(pos0 < CL ? 16 : bb) * 6144 + modidx * 1024;
#pragma unroll
    for (int b = 0; b < NTW; ++b) {
      int col = n0 + wn * 32 * NTW + b * 32 + r;
      float mv = mrow[col];
      float xv[MT][16];
#pragma unroll
      for (int a = 0; a < MT; ++a) {
        const float* sp = src + (size_t)(wm * 32 * MT + a * 32 + 4 * h) * DM + col;
#pragma unroll
        for (int i = 0; i < 16; ++i) xv[a][i] = sp[(size_t)(8 * (i >> 2) + (i & 3)) * DM];
      }
#pragma unroll
      for (int a = 0; a < MT; ++a) {
        float* dp = dst + (size_t)(wm * 32 * MT + a * 32 + 4 * h) * DM + col;
#pragma unroll
        for (int i = 0; i < 16; ++i) dp[(size_t)(8 * (i >> 2) + (i & 3)) * DM] = xv[a][i] + mv * acc[a][b][i];
      }
      __builtin_amdgcn_sched_barrier(0);
    }
  }
}

template <int MT, int EPI>
DI void gemm_phase(const Params& p, const u16* A, int lda, const u16* Bt, int K, int ntn, char* smem,
                           int l, int modidx, bool from_input, bool skip_ctx) {
  constexpr int BM = 64 * MT;
  constexpr int TPB = NP / BM;
  constexpr int CPB = CL / BM;
  const int ntm = skip_ctx ? NB * (TPB - CPB) : NB * TPB;
  if (blockIdx.x >= (gridDim.x >> 1)) __builtin_amdgcn_s_sleep(48);
  const int xcd = blockIdx.x & 7, jb = blockIdx.x >> 3, nbx = gridDim.x >> 3;
  const int msplit = (EPI == 1) ? 8 : 2, nsplit = 8 / msplit;
  const int mi = xcd / nsplit, ni = xcd % nsplit;
  const int mpx = ntm / msplit;
  const int nper = (ntn + nsplit - 1) / nsplit;
  const int nlo = ni * nper, nw = min(ntn, nlo + nper) - nlo;
  const int total = mpx * nw;
  int nfull = total;
  if (EPI == 1) {
    const int rem = total % nbx;
    if (rem > 0 && rem * 2 <= nbx) nfull = total - rem;
  }
  for (int t = jb; t < nfull; t += nbx) {
    int mtc = mi * mpx + t / nw, nt = nlo + t % nw;
    int mt = skip_ctx ? (mtc / (TPB - CPB)) * TPB + CPB + (mtc % (TPB - CPB)) : mtc;
    int m0 = mt * BM;
    if (EPI == 0 && l == 1 && (m0 % NP) < CL && nt < 8) continue;
    gemm_tile<MT, EPI>(p, A, lda, Bt, K, m0, nt * 128, smem, l, modidx, from_input);
  }
  if (EPI == 1 && nfull < total && jb < 2 * (total - nfull)) {
    int t = nfull + (jb >> 1);
    int mtc = mi * mpx + t / nw, nt = nlo + t % nw;
    int mt = skip_ctx ? (mtc / (TPB - CPB)) * TPB + CPB + (mtc % (TPB - CPB)) : mtc;
    gemm_tile<MT, EPI, 1>(p, A, lda, Bt, K, mt * BM, nt * 128 + (jb & 1) * 64, smem, l, modidx, from_input);
  }
}

template <int KK, int NT>
DI void small_gemm(const u16* As, int lda, const u16* __restrict__ Bt, int ldb, int n0, f32x16* acc) {
  const int lane = lane_id_(), r = lane & 31, h = lane >> 5;
#pragma unroll
  for (int t = 0; t < NT; ++t)
#pragma unroll
    for (int i = 0; i < 16; ++i) acc[t][i] = 0.f;
  const u16* bp = Bt + (size_t)(n0 + r) * ldb + h * 8;
  const u16* ap = As + r * lda + h * 8;
#pragma unroll
  for (int s0 = 0; s0 < KK / 16; s0 += 4) {
    bf16x8 a[4], b[4][NT];
#pragma unroll
    for (int s = 0; s < 4; ++s) {
      a[s] = *(const bf16x8*)(ap + (s0 + s) * 16);
#pragma unroll
      for (int t = 0; t < NT; ++t) b[s][t] = *(const bf16x8*)(bp + (size_t)(t * 32) * ldb + (s0 + s) * 16);
    }
#pragma unroll
    for (int s = 0; s < 4; ++s)
#pragma unroll
      for (int t = 0; t < NT; ++t) acc[t] = MFMA(a[s], b[s][t], acc[t]);
    __builtin_amdgcn_sched_barrier(0);
  }
}

struct TileInfo { int g0, b, pos0, lo, hi; };
DI TileInfo tile_info(int tile) {
  TileInfo t;
  t.g0 = tile * 32; t.b = t.g0 / NP; t.pos0 = t.g0 - t.b * NP;
  if (t.pos0 < CL) { t.lo = 0; t.hi = CL; } else { t.lo = CL; t.hi = NP; }
  return t;
}

DI void unpack8(const u32x4& v, float* f) {
#pragma unroll
  for (int k = 0; k < 4; ++k) { f[2 * k] = bflo(v[k]); f[2 * k + 1] = bfhi(v[k]); }
}
DI u32x4 pack8(const float* f) {
  u32x4 o;
#pragma unroll
  for (int k = 0; k < 4; ++k) o[k] = pack2(f[2 * k], f[2 * k + 1]);
  return o;
}
DI u32x4 pack8t(const float* f) {
  u32x4 o;
#pragma unroll
  for (int k = 0; k < 4; ++k) o[k] = (unsigned)f2bf(f[2 * k]) | (__float_as_uint(f[2 * k + 1]) & 0xffff0000u);
  return o;
}
DI void load8f(const float* q, float* f) {
  float4 a = *(const float4*)q, b = *(const float4*)(q + 4);
  f[0] = a.x; f[1] = a.y; f[2] = a.z; f[3] = a.w; f[4] = b.x; f[5] = b.y; f[6] = b.z; f[7] = b.w;
}
DI void lds8f(const float* q, float* f) { load8f(q, f); }

template <int NT>
DI void stage_acc(u16* O, int ldo, int col0, const f32x16* acc, int r, int h, float scale) {
#pragma unroll
  for (int t = 0; t < NT; ++t)
#pragma unroll
    for (int i = 0; i < 16; ++i) O[crow(i, h) * ldo + col0 + t * 32 + r] = f2bf(acc[t][i] * scale);
}

DI void prep_conv(const Params& pp, int l, int tile, char* smem) {
  const PW p = {opaque_p(pp.ws), pp.out, pp.wave64};
  const TileInfo ti = tile_info(tile);
  const u16* P = (const u16*)(p.ws + WS_BIG + BIG_P);
  u16* Ycat = (u16*)(p.ws + WS_H);
  u16* U = (u16*)smem;
  u16* Wb = (u16*)(smem + 31744);
  u16* A = (u16*)smem;
  u16* O = (u16*)(smem + 16896);
  const int tid = opaque(TIDX), lane = tid & 63, wave = tid >> 6, r = lane & 31, h = lane >> 5;
  const int cg = tid & 31, tq = tid >> 5, c0 = cg * 8;
  __syncthreads();
  {
    const float* dw = IN(10) + (size_t)l * 31 * 256;
#pragma unroll 8
    for (int j = 0; j < 31; ++j) Wb[j * 256 + tid] = f2bf(dw[j * 256 + tid]);
  }
#pragma unroll 4
  for (int i = 0; i < 8; ++i) {
    int e = tid + 256 * i;
    if (e < 62 * 32) {
      int tt = e >> 5, g8 = e & 31;
      int pos = ti.pos0 - 15 + tt;
      bool valid = (pos >= ti.lo) && (pos < ti.hi);
      int pc = min(max(pos, ti.lo), ti.hi - 1);
      const u16* pr = P + (size_t)(ti.b * NP + pc) * PIN + g8 * 8;
      u32x4 va = *(const u32x4*)pr, vg = *(const u32x4*)(pr + 256);
      float fa[8], fg[8];
      unpack8(va, fa); unpack8(vg, fg);
#pragma unroll
      for (int k = 0; k < 8; ++k) fa[k] = valid ? fa[k] * sigm(fg[k]) : 0.f;
      *(u32x4*)(U + tt * 256 + g8 * 8) = pack8(fa);
    }
  }
  __syncthreads();
  float y[4][8];
#pragma unroll
  for (int t = 0; t < 4; ++t)
#pragma unroll
    for (int e = 0; e < 8; ++e) y[t][e] = 0.f;
  {
    float uw[4][8];
#pragma unroll
    for (int t = 0; t < 3; ++t) unpack8(*(const u32x4*)(U + (4 * tq + t) * 256 + c0), uw[t + 1]);
#pragma unroll 1
    for (int j = 0; j < 31; ++j) {
#pragma unroll
      for (int e = 0; e < 8; ++e) { uw[0][e] = uw[1][e]; uw[1][e] = uw[2][e]; uw[2][e] = uw[3][e]; }
      unpack8(*(const u32x4*)(U + (4 * tq + j + 3) * 256 + c0), uw[3]);
      float w8[8];
      unpack8(*(const u32x4*)(Wb + j * 256 + c0), w8);
#pragma unroll
      for (int t = 0; t < 4; ++t)
#pragma unroll
        for (int e = 0; e < 8; ++e) y[t][e] += uw[t][e] * w8[e];
    }
  }
  {
    float db[8], gg[8], gb[8];
    load8f(IN(11) + l * 256 + c0, db); load8f(IN(12) + l * 256 + c0, gg); load8f(IN(13) + l * 256 + c0, gb);
#pragma unroll
    for (int t = 0; t < 4; ++t) {
      float sm = 0.f;
#pragma unroll
      for (int e = 0; e < 8; ++e) { y[t][e] += db[e]; sm += y[t][e]; }
      const float mean = sum8(sm) * (1.f / 64.f);
      float sq = 0.f;
#pragma unroll
      for (int e = 0; e < 8; ++e) { y[t][e] -= mean; sq += y[t][e] * y[t][e]; }
      const float rs = rsqrtf(sum8(sq) * (1.f / 64.f) + 1e-5f);
#pragma unroll
      for (int e = 0; e < 8; ++e) { float gn = y[t][e] * rs * gg[e] + gb[e]; y[t][e] = gn * sigm(gn); }
    }
  }
  __syncthreads();
#pragma unroll
  for (int t = 0; t < 4; ++t) *(u32x4*)(A + (4 * tq + t) * 264 + c0) = pack8(y[t]);
  __syncthreads();
  f32x16 acc[2];
  small_gemm<256, 2>(A, 264, (const u16*)(p.ws + WS_WT) + WT_PW, 256, wave * 64, acc);
  stage_acc<2>(O, 264, wave * 64, acc, r, h, 1.f);
  __syncthreads();
#pragma unroll
  for (int i = 0; i < 4; ++i) {
    int e = tid + 256 * i, row = e >> 5, cc = e & 31;
    *(u32x4*)(Ycat + (size_t)(ti.g0 + row) * DM + cc * 8) = *(const u32x4*)(O + row * 264 + cc * 8);
  }
}

template <int W>
DI void pool_body(const float* u, float* d, int pos0, int lo, int hi) {
  const int vz = opaque(0);
#pragma unroll
  for (int t = 0; t < 32; ++t) {
    float s = 0.f;
#pragma unroll
    for (int j = 0; j < W; ++j) s += u[t + 8 - W / 2 + j];
    int pos = pos0 + t + vz;
    int a = max(pos - W / 2, lo), b = min(pos + W / 2, hi);
    d[t] = s / (float)(b - a) - u[t + 8];
  }
}

DI void prep_pool(const Params& pp, int l, int tile, char* smem) {
  const PW p = {opaque_p(pp.ws), pp.out, pp.wave64};
  const TileInfo ti = tile_info(tile);
  const u16* P = (const u16*)(p.ws + WS_BIG + BIG_P);
  u16* Ycat = (u16*)(p.ws + WS_H);
  u16* A = (u16*)smem;
  const int tid = opaque(TIDX), c = tid, lane = tid & 63, wave = tid >> 6, r = lane & 31, h = lane >> 5;
  float u[47];
#pragma unroll
  for (int tt = 0; tt < 47; ++tt) {
    int pos = ti.pos0 - 8 + tt;
    bool valid = (pos >= ti.lo) && (pos < ti.hi);
    int pc = min(max(pos, ti.lo), ti.hi - 1);
    float uv = bf2f(P[(size_t)(ti.b * NP + pc) * PIN + OFF_POOL + c]);
    u[tt] = valid ? uv : 0.f;
  }
  float d[32];
  if (wave == 0) pool_body<2>(u, d, ti.pos0, ti.lo, ti.hi);
  else if (wave == 1) pool_body<4>(u, d, ti.pos0, ti.lo, ti.hi);
  else if (wave == 2) pool_body<8>(u, d, ti.pos0, ti.lo, ti.hi);
  else pool_body<16>(u, d, ti.pos0, ti.lo, ti.hi);
  __syncthreads();
#pragma unroll
  for (int t = 0; t < 32; ++t) A[t * 264 + c] = f2bf(d[t]);
  __syncthreads();
  f32x16 acc[2];
  small_gemm<64, 2>(A + wave * 64, 264, (const u16*)(p.ws + WS_WT) + WT_POOL + wave * 4096, 64, 0, acc);
  u16* O = (u16*)(smem + 16896);
#pragma unroll
  for (int t = 0; t < 2; ++t) {
    int n = wave * 64 + t * 32 + r;
    float sc = IN(16)[l * 256 + n];
#pragma unroll
    for (int i = 0; i < 16; ++i) O[crow(i, h) * 264 + n] = f2bf(acc[t][i] * sc);
  }
  __syncthreads();
#pragma unroll
  for (int i = 0; i < 4; ++i) {
    int e = tid + 256 * i, row = e >> 5, cc = e & 31;
    *(u32x4*)(Ycat + (size_t)(ti.g0 + row) * DM + 512 + cc * 8) = *(const u32x4*)(O + row * 264 + cc * 8);
  }
}

DI float rope_freq(int f) { return exp2f(-(float)f * 1.6609640474436813f); }

DI void prep_q(const Params& pp, int l, int tile, char* smem) {
  const PW p = {opaque_p(pp.ws), pp.out, pp.wave64};
  const TileInfo ti = tile_info(tile);
  const u16* P = (const u16*)(p.ws + WS_BIG + BIG_P);
  u16* Q = (u16*)(p.ws + WS_BIG + BIG_Q);
  u16* A = (u16*)smem;
  const int tid = opaque(TIDX), lane = tid & 63, wave = tid >> 6, r = lane & 31, h = lane >> 5;
  {
    const int t = tid >> 3, j = tid & 7;
    const u16* src = P + (size_t)(ti.g0 + t) * PIN + OFF_Q + j * 32;
    u32x4 v[4];
    float ss = 0.f;
#pragma unroll
    for (int i = 0; i < 4; ++i) {
      v[i] = *(const u32x4*)(src + i * 8);
#pragma unroll
      for (int k = 0; k < 4; ++k) { float a = bflo(v[i][k]), b = bfhi(v[i][k]); ss += a * a + b * b; }
    }
    ss = sum8(ss);
    float rs = rsqrtf(ss * (1.f / 256.f) + 1e-6f);
    const float* qg = IN(29) + l * 256 + j * 32;
    __syncthreads();
#pragma unroll
    for (int i = 0; i < 4; ++i) {
      u32x4 o;
#pragma unroll
      for (int k = 0; k < 4; ++k) {
        float a = bflo(v[i][k]) * rs * qg[i * 8 + 2 * k], b = bfhi(v[i][k]) * rs * qg[i * 8 + 2 * k + 1];
        o[k] = pack2(a, b);
      }
      *(u32x4*)(A + t * 264 + j * 32 + i * 8) = o;
    }
  }
  __syncthreads();
  f32x16 acc[3];
  small_gemm<256, 3>(A, 264, (const u16*)(p.ws + WS_WT) + WT_WUQ, 256, wave * 96, acc);
  const float QS = 0.10206207261596577f * 1.4426950408889634f;
  u16* O = (u16*)(smem + 16896);
  stage_acc<2>(O, 392, wave * 96, acc, r, h, QS);
  const bool lat = ti.pos0 >= CL;
  const float fr = rope_freq(r & 7);
#pragma unroll
  for (int i = 0; i < 16; ++i) {
    float val = acc[2][i];
    float par = __shfl_xor(val, 8, 64);
    int tk = crow(i, h);
    float o = val;
    if (lat) {
      int n = ti.pos0 + tk - CL;
      float pa = (float)((r < 16) ? (n >> 6) : (n & 63));
      float ang = pa * fr;
      float sn = __sinf(ang), cs = __cosf(ang);
      o = (r & 8) ? (par * sn + val * cs) : (val * cs - par * sn);
    }
    O[tk * 392 + wave * 96 + 64 + r] = f2bf(o * QS);
  }
  __syncthreads();
#pragma unroll
  for (int i = 0; i < 6; ++i) {
    int e = tid + 256 * i, row = e / 48, cc = e - row * 48;
    *(u32x4*)(Q + (size_t)(ti.g0 + row) * 384 + cc * 8) = *(const u32x4*)(O + row * 392 + cc * 8);
  }
}

DI void prep_kv(const Params& pp, int l, int tile, char* smem) {
  const PW p = {opaque_p(pp.ws), pp.out, pp.wave64};
  const TileInfo ti = tile_info(tile);
  const u16* P = (const u16*)(p.ws + WS_BIG + BIG_P);
  u16* KN = (u16*)(p.ws + WS_BIG + BIG_KN);
  u16* KR = (u16*)(p.ws + WS_BIG + BIG_KR);
  u16* VT = (u16*)(p.ws + WS_BIG + BIG_VT);
  u16* A = (u16*)smem;
  const int tid = opaque(TIDX), lane = tid & 63, wave = tid >> 6, r = lane & 31, h = lane >> 5;
  const bool lat = ti.pos0 >= CL;
  {
    const int t = tid >> 3, j = tid & 7;
    const u16* src = P + (size_t)(ti.g0 + t) * PIN + OFF_KV + j * 16;
    u32x4 v[2];
    float ss = 0.f;
#pragma unroll
    for (int i = 0; i < 2; ++i) {
      v[i] = *(const u32x4*)(src + i * 8);
#pragma unroll
      for (int k = 0; k < 4; ++k) { float a = bflo(v[i][k]), b = bfhi(v[i][k]); ss += a * a + b * b; }
    }
    ss = sum8(ss);
    float rs = rsqrtf(ss * (1.f / 128.f) + 1e-6f);
    const float* kg = IN(31) + l * 128 + j * 16;
    __syncthreads();
#pragma unroll
    for (int i = 0; i < 2; ++i) {
      u32x4 o;
#pragma unroll
      for (int k = 0; k < 4; ++k) {
        float a = bflo(v[i][k]) * rs * kg[i * 8 + 2 * k], b = bfhi(v[i][k]) * rs * kg[i * 8 + 2 * k + 1];
        o[k] = pack2(a, b);
      }
      *(u32x4*)(A + t * 136 + j * 16 + i * 8) = o;
    }
  }
#pragma unroll
  for (int i = 0; i < 4; ++i) {
    int e = tid + 256 * i, t = e >> 5, dd = e & 31;
    const u16* src = P + (size_t)(ti.g0 + t) * PIN + OFF_KV + 128;
    float val = bf2f(src[dd]), par = bf2f(src[dd ^ 8]);
    float o = val;
    if (lat) {
      int n = ti.pos0 + t - CL;
      float pa = (float)((dd < 16) ? (n >> 6) : (n & 63));
      float ang = pa * rope_freq(dd & 7);
      float sn = __sinf(ang), cs = __cosf(ang);
      o = (dd & 8) ? (par * sn + val * cs) : (val * cs - par * sn);
    }
    KR[(size_t)(ti.g0 + t) * 32 + dd] = f2bf(o);
  }
  __syncthreads();
  f32x16 acc[4];
  small_gemm<128, 4>(A, 136, (const u16*)(p.ws + WS_WT) + WT_WUKV, 128, wave * 128, acc);
  u16* O = (u16*)(smem + 16896);
  stage_acc<2>(O, 264, wave * 64, acc, r, h, 1.f);
#pragma unroll
  for (int t = 0; t < 2; ++t) {
    int dv = t * 32 + r;
    u16* dst = VT + ((size_t)((ti.b * 4 + wave) * 64 + dv)) * NP + ti.pos0;
#pragma unroll
    for (int q = 0; q < 4; ++q) {
      u32x2 o;
      o[0] = pack2(acc[2 + t][4 * q], acc[2 + t][4 * q + 1]);
      o[1] = pack2(acc[2 + t][4 * q + 2], acc[2 + t][4 * q + 3]);
      *(u32x2*)(dst + 8 * q + 4 * h) = o;
    }
  }
  __syncthreads();
#pragma unroll
  for (int i = 0; i < 4; ++i) {
    int e = tid + 256 * i, row = e >> 5, cc = e & 31;
    *(u32x4*)(KN + (size_t)(ti.g0 + row) * 256 + cc * 8) = *(const u32x4*)(O + row * 264 + cc * 8);
  }
}

DI void mix4(const u16* Pcol, const TileInfo& ti, int t0, const float* mp, const float* mn, float (*z)[8]) {
  u32x4 raw[6];
#pragma unroll
  for (int i = 0; i < 6; ++i) {
    int pos = ti.pos0 + t0 - 1 + i;
    bool ok = (pos >= ti.lo) && (pos < ti.hi);
    int pc = min(max(pos, ti.lo), ti.hi - 1);
    u32x4 v = *(const u32x4*)(Pcol + (size_t)(ti.b * NP + pc) * PIN);
    if (!ok) { v[0] = 0u; v[1] = 0u; v[2] = 0u; v[3] = 0u; }
    raw[i] = v;
  }
#pragma unroll
  for (int t = 0; t < 4; ++t) {
    float fp[8], fc[8], fn[8];
    unpack8(raw[t], fp); unpack8(raw[t + 1], fc); unpack8(raw[t + 2], fn);
#pragma unroll
    for (int e = 0; e < 8; ++e) z[t][e] = fc[e] + mp[e] * (fp[e] - fc[e]) + mn[e] * (fn[e] - fc[e]);
  }
}

DI void prep_rwkv(const Params& pp, int l, int tile, char* smem) {
  const PW p = {opaque_p(pp.ws), pp.out, pp.wave64};
  const TileInfo ti = tile_info(tile);
  const u16* P = (const u16*)(p.ws + WS_BIG + BIG_P);
  u16* Ycat = (u16*)(p.ws + WS_H);
  u16* SR = (u16*)(p.ws + WS_BIG + BIG_SR);
  u16* SKK = (u16*)(p.ws + WS_BIG + BIG_SKK);
  u16* SV = (u16*)(p.ws + WS_BIG + BIG_SV);
  u16* A3 = (u16*)smem;
  float* R = (float*)(smem + 25088);
  const u16* wt = (const u16*)(p.ws + WS_WT);
  const int tid = opaque(TIDX), lane = tid & 63, wave = tid >> 6, r = lane & 31, h = lane >> 5;
  const int cg = tid & 31, tq = tid >> 5, c0 = cg * 8, t0 = tq * 4;
  const float* mup = IN(17) + l * 1152;
  const float* mun = IN(18) + l * 1152;
  __syncthreads();
#pragma unroll 2
  for (int i = 0; i < 6; ++i) {
    int e = tid + 256 * i, t = e / 48, jg = e - t * 48, j0 = jg * 8;
    int pos = ti.pos0 + t;
    const u16* pr = P + (size_t)(ti.g0 + t) * PIN + OFF_RW + 768 + j0;
    const bool hp = pos > ti.lo, hn = pos + 1 < ti.hi;
    u32x4 vc = *(const u32x4*)pr;
    u32x4 vp = *(const u32x4*)(pr + (hp ? -PIN : 0));
    u32x4 vn = *(const u32x4*)(pr + (hn ? PIN : 0));
    float fc[8], fp[8], fn[8], mp[8], mn[8], z[8];
    unpack8(vc, fc); unpack8(vp, fp); unpack8(vn, fn);
    load8f(mup + 768 + j0, mp); load8f(mun + 768 + j0, mn);
#pragma unroll
    for (int k = 0; k < 8; ++k) {
      float pv = hp ? fp[k] : 0.f, nx = hn ? fn[k] : 0.f;
      float zz = fc[k] + mp[k] * (pv - fc[k]) + mn[k] * (nx - fc[k]);
      float sg = sigm((jg < 16) ? zz : 2.f * zz);
      z[k] = (jg < 16) ? sg : ((jg < 32) ? (2.f * sg - 1.f) : zz);
    }
    *(u32x4*)(A3 + t * 392 + j0) = pack8(z);
  }
  float zk[4][8], rzk[4][8];
  {
    float mp[8], mn[8], z[4][8];
    load8f(mup + c0, mp); load8f(mun + c0, mn);
    mix4(P + OFF_RW + c0, ti, t0, mp, mn, z);
    float rkw[8];
    load8f(IN(26) + l * 256 + c0, rkw);
#pragma unroll
    for (int t = 0; t < 4; ++t) {
      *(u32x4*)(SR + (size_t)(ti.g0 + t0 + t) * 256 + c0) = pack8t(z[t]);
#pragma unroll
      for (int e = 0; e < 8; ++e) rzk[t][e] = z[t][e] * rkw[e];
    }
    load8f(mup + 512 + c0, mp); load8f(mun + 512 + c0, mn);
    mix4(P + OFF_RW + 512 + c0, ti, t0, mp, mn, z);
#pragma unroll
    for (int t = 0; t < 4; ++t) *(u32x4*)(SV + (size_t)(ti.g0 + t0 + t) * 256 + c0) = pack8(z[t]);
    load8f(mup + 256 + c0, mp); load8f(mun + 256 + c0, mn);
    mix4(P + OFF_RW + 256 + c0, ti, t0, mp, mn, zk);
    float kkw[8];
    load8f(IN(24) + l * 256 + c0, kkw);
#pragma unroll
    for (int t = 0; t < 4; ++t) {
      float kk[8], ss = 0.f;
#pragma unroll
      for (int e = 0; e < 8; ++e) { kk[e] = zk[t][e] * kkw[e]; ss += kk[e] * kk[e]; rzk[t][e] *= zk[t][e]; }
      ss = sum8(ss);
      float inv = 1.f / fmaxf(sqrtf(ss), 1e-12f);
#pragma unroll
      for (int e = 0; e < 8; ++e) kk[e] *= inv;
      *(u32x4*)(SKK + (size_t)(ti.g0 + t0 + t) * 256 + c0) = pack8t(kk);
    }
  }
  __syncthreads();
  f32x16 acc[2];
  small_gemm<128, 2>(A3, 392, wt + WT_RG2, 128, wave * 64, acc);
#pragma unroll
  for (int t = 0; t < 2; ++t)
#pragma unroll
    for (int i = 0; i < 16; ++i) R[crow(i, h) * 260 + wave * 64 + t * 32 + r] = acc[t][i];
  __syncthreads();
#pragma unroll
  for (int t = 0; t < 4; ++t) {
    float g8[8];
    lds8f(R + (t0 + t) * 260 + c0, g8);
    *(u32x4*)(Ycat + (size_t)(ti.g0 + t0 + t) * DM + 256 + c0) = pack8(g8);
  }
  __syncthreads();
  float ka[8];
  load8f(IN(25) + l * 256 + c0, ka);
#pragma unroll 1
  for (int d = 0; d < 2; ++d) {
    u16* SDEC = (u16*)(p.ws + WS_BIG + BIG_SDEC) + (size_t)d * NTOK * 256;
    u16* SKD = (u16*)(p.ws + WS_BIG + BIG_SKD) + (size_t)d * NTOK * 256;
    u16* SB = (u16*)(p.ws + WS_BIG + BIG_SB) + (size_t)d * NTOK * 256;
    float* bo = (float*)(p.ws + WS_BONUS) + (size_t)d * NTOK * 4;
    small_gemm<64, 2>(A3 + 128 + d * 64, 392, wt + WT_RW2 + d * 16384, 64, wave * 64, acc);
#pragma unroll
    for (int t = 0; t < 2; ++t)
#pragma unroll
      for (int i = 0; i < 16; ++i) R[crow(i, h) * 260 + wave * 64 + t * 32 + r] = acc[t][i];
    __syncthreads();
    {
      float w0[8];
      load8f(IN(19) + l * 512 + d * 256 + c0, w0);
#pragma unroll
      for (int t = 0; t < 4; ++t) {
        float x8[8];
        lds8f(R + (t0 + t) * 260 + c0, x8);
#pragma unroll
        for (int e = 0; e < 8; ++e) {
          float ee = sigm(w0[e] + x8[e]) * 0.6065306597126334f;
          x8[e] = 1.f - __expf(-ee);
        }
        *(u32x4*)(SDEC + (size_t)(ti.g0 + t0 + t) * 256 + c0) = pack8t(x8);
      }
    }
    __syncthreads();
    small_gemm<64, 2>(A3 + 256 + d * 64, 392, wt + WT_RA2 + d * 16384, 64, wave * 64, acc);
#pragma unroll
    for (int t = 0; t < 2; ++t)
#pragma unroll
      for (int i = 0; i < 16; ++i) R[crow(i, h) * 260 + wave * 64 + t * 32 + r] = acc[t][i];
    __syncthreads();
    {
      float a0[8];
      load8f(IN(21) + l * 512 + d * 256 + c0, a0);
      u32x4 kraw[4];
#pragma unroll
      for (int t = 0; t < 4; ++t) kraw[t] = *(const u32x4*)(SKK + (size_t)(ti.g0 + t0 + t) * 256 + c0);
#pragma unroll
      for (int t = 0; t < 4; ++t) {
        float x8[8], kn[8], kd[8], bb[8], part = 0.f;
        lds8f(R + (t0 + t) * 260 + c0, x8);
        unpack8(kraw[t], kn);
#pragma unroll
        for (int e = 0; e < 8; ++e) {
          float a = sigm(a0[e] + x8[e]);
          float kf = 1.f + (a - 1.f) * ka[e];
          kd[e] = zk[t][e] * kf;
          bb[e] = kn[e] * a;
          part += rzk[t][e] * kf;
        }
        size_t o = (size_t)(ti.g0 + t0 + t) * 256 + c0;
        *(u32x4*)(SKD + o) = pack8t(kd);
        *(u32x4*)(SB + o) = pack8t(bb);
        part = sum8(part);
        if ((cg & 7) == 0) bo[(size_t)(ti.g0 + t0 + t) * 4 + (cg >> 3)] = part;
      }
    }
    __syncthreads();
  }
}

DI void prep_phase(const Params& p, int l, char* smem) {
  const int NT = NTOK / 32;
  for (int item = blockIdx.x; item < 3 * NT; item += gridDim.x) {
    int task = item / NT, tile = item - task * NT;
    bool ctx = (tile % 72) < 8;
    if (l == 1 && ctx && task == 1) continue;
    if (task == 0) prep_rwkv(p, l, tile, smem);
    else if (task == 1) prep_q(p, l, tile, smem);
    else prep_kv(p, l, tile, smem);
  }
}

DI void scan_item(const Params& pp, int item, char* smem) {
  const PW p = {opaque_p(pp.ws), pp.out, pp.wave64};
  const int rh = item & 1, d = (item >> 1) & 1, hd = (item >> 2) & 3, b = item >> 4;
  const int tid = opaque(TIDX), rowl = tid >> 3, ks = tid & 7;
  const u16* arr[5];
  arr[0] = (const u16*)(p.ws + WS_BIG + BIG_SR);
  arr[1] = (const u16*)(p.ws + WS_BIG + BIG_SKK);
  arr[2] = (const u16*)(p.ws + WS_BIG + BIG_SDEC) + (size_t)d * NTOK * 256;
  arr[3] = (const u16*)(p.ws + WS_BIG + BIG_SKD) + (size_t)d * NTOK * 256;
  arr[4] = (const u16*)(p.ws + WS_BIG + BIG_SB) + (size_t)d * NTOK * 256;
  const u16* SV = (const u16*)(p.ws + WS_BIG + BIG_SV);
  constexpr int CH = 32, BUFB = CH * 640 + CH * 64;
  int sj[5], soff[5];
  const u16* sbase[5];
#pragma unroll
  for (int i = 0; i < 5; ++i) {
    int e = tid + 256 * i, j = e / 40, rem = e - j * 40, a = rem >> 3, part = rem & 7;
    sj[i] = j; soff[i] = j * 640 + a * 128 + part * 16;
    sbase[i] = (a == 0 ? arr[0] : a == 1 ? arr[1] : a == 2 ? arr[2] : a == 3 ? arr[3] : arr[4]) + hd * 64 + part * 8;
  }
  const int vj = (tid >> 2) & 31, vpart = tid & 3;
  const u16* vbase = SV + hd * 64 + rh * 32 + vpart * 8;
  const int voff = CH * 640 + vj * 64 + vpart * 16;
  u32x4 rg[6];
  auto pos_of = [&](int s) -> int { return d == 0 ? s : (s < CL ? (CL - 1 - s) : (NP + CL - 1 - s)); };
  auto gload = [&](int cidx) {
#pragma unroll
    for (int i = 0; i < 5; ++i) {
      size_t g = (size_t)b * NP + pos_of(cidx * CH + sj[i]);
      rg[i] = *(const u32x4*)(sbase[i] + g * 256);
    }
    if (tid < 128) {
      size_t g = (size_t)b * NP + pos_of(cidx * CH + vj);
      rg[5] = *(const u32x4*)(vbase + g * 256);
    }
  };
  auto lstore = [&](int bufi) {
    char* bp = smem + bufi * BUFB;
#pragma unroll
    for (int i = 0; i < 5; ++i) *(u32x4*)(bp + soff[i]) = rg[i];
    if (tid < 128) *(u32x4*)(bp + voff) = rg[5];
  };
  f2 S[4];
#pragma unroll
  for (int j = 0; j < 4; ++j) S[j] = (f2){0.f, 0.f};
  constexpr int NCH = NP / CH;
  float* Yb = (float*)(smem + 2 * BUFB);
  const int wj = tid >> 3, wp = tid & 7;
  __syncthreads();
  gload(0);
  lstore(0);
  gload(1);
  __syncthreads();
  for (int cidx = 0; cidx < NCH; ++cidx) {
    if (cidx + 1 < NCH) lstore((cidx + 1) & 1);
    if (cidx + 2 < NCH) gload(cidx + 2);
    if (cidx > 0) {
      u32x4 yv = *(const u32x4*)(Yb + ((cidx - 1) & 1) * CH * 32 + wj * 32 + wp * 4);
      size_t g = (size_t)b * NP + pos_of((cidx - 1) * CH + wj);
      *(u32x4*)(yrow(p.ws, g, d) + hd * 64 + rh * 32 + wp * 4) = yv;
    }
    const char* bp = smem + (cidx & 1) * BUFB;
    float* yb = Yb + (cidx & 1) * CH * 32;
#pragma unroll 4
    for (int j = 0; j < CH; ++j) {
      const char* sp = bp + j * 640 + ks * 16;
      u32x4 r8 = *(const u32x4*)(sp);
      u32x4 k8 = *(const u32x4*)(sp + 128);
      u32x4 d8 = *(const u32x4*)(sp + 256);
      u32x4 kd8 = *(const u32x4*)(sp + 384);
      u32x4 b8 = *(const u32x4*)(sp + 512);
      float vv = bf2f(*(const u16*)(bp + CH * 640 + j * 64 + rowl * 2));
      f2 K2[4], R2[4], D2[4], KD2[4], B2[4];
#define UNPK(dst, src)                                                                   \
      dst[0] = __builtin_bit_cast(f2, __builtin_shufflevector(src, src, 0, 1));           \
      dst[1] = __builtin_bit_cast(f2, __builtin_shufflevector(src, src, 2, 3));           \
      dst[2] = (f2){bflo(src[0]), bflo(src[1])};                                          \
      dst[3] = (f2){bflo(src[2]), bflo(src[3])};
      UNPK(K2, k8) UNPK(R2, r8) UNPK(D2, d8) UNPK(KD2, kd8) UNPK(B2, b8)
#undef UNPK
      f2 sa2 = S[0] * K2[0];
      f2 sb2 = S[1] * K2[1];
      sa2 = S[2] * K2[2] + sa2;
      sb2 = S[3] * K2[3] + sb2;
      sa2 = sa2 + sb2;
      const float sa = sum8(sa2.x + sa2.y);
      const f2 vv2 = (f2){vv, vv}, san = (f2){-sa, -sa};
      f2 y2 = (f2){0.f, 0.f}, y3 = (f2){0.f, 0.f};
#pragma unroll
      for (int q = 0; q < 4; ++q) {
        f2 t = vv2 * KD2[q];
        t = san * B2[q] + t;
        f2 sn = S[q] - S[q] * D2[q];
        sn = sn + t;
        S[q] = sn;
        if (q & 1) y3 = sn * R2[q] + y3; else y2 = sn * R2[q] + y2;
      }
      y2 = y2 + y3;
      const float y = sum8(y2.x + y2.y);
      if (ks == 0) yb[j * 32 + rowl] = y;
    }
    __syncthreads();
  }
  {
    u32x4 yv = *(const u32x4*)(Yb + ((NCH - 1) & 1) * CH * 32 + wj * 32 + wp * 4);
    size_t g = (size_t)b * NP + pos_of((NCH - 1) * CH + wj);
    *(u32x4*)(yrow(p.ws, g, d) + hd * 64 + rh * 32 + wp * 4) = yv;
  }
}

DI void attn_item(const Params& pp, int item, char* smem) {
  const PW p = {opaque_p(pp.ws), pp.out, pp.wave64};
  int b, hd, q0, nkt;
  if (item < 1024) { b = item >> 6; hd = (item >> 4) & 3; q0 = CL + (item & 15) * 128; nkt = NP / 64; }
  else { int x = item - 1024; b = x >> 3; hd = (x >> 1) & 3; q0 = (x & 1) * 128; nkt = CL / 64; }
  const u16* Q = (const u16*)(p.ws + WS_BIG + BIG_Q);
  const u16* KN = (const u16*)(p.ws + WS_BIG + BIG_KN);
  const u16* KR = (const u16*)(p.ws + WS_BIG + BIG_KR);
  const u16* VT = (const u16*)(p.ws + WS_BIG + BIG_VT);
  u16* Ycat = (u16*)(p.ws + WS_H);
  u16* Ks = (u16*)smem;
  u16* Vs = Ks + 64 * 104;
  const int tid = opaque(TIDX), lane = tid & 63, wave = tid >> 6, r = lane & 31, h = lane >> 5;
  const size_t gq = (size_t)b * NP + q0 + wave * 32 + r;
  bf16x8 qf[6];
#pragma unroll
  for (int s = 0; s < 6; ++s) qf[s] = *(const bf16x8*)(Q + gq * 384 + hd * 96 + s * 16 + h * 8);
  f32x16 oacc[2];
#pragma unroll
  for (int t = 0; t < 2; ++t)
#pragma unroll
    for (int i = 0; i < 16; ++i) oacc[t][i] = 0.f;
  float m = -1e30f, lsum = 0.f;
  u32x4 rk[3], rv[2];
  auto gload = [&](int kt) {
    const size_t gk0 = (size_t)b * NP + kt * 64;
#pragma unroll
    for (int i = 0; i < 3; ++i) {
      int e = tid + 256 * i, key = e / 12, part = e - key * 12;
      const u16* src = (part < 8) ? (KN + (gk0 + key) * 256 + hd * 64 + part * 8) : (KR + (gk0 + key) * 32 + (part - 8) * 8);
      rk[i] = *(const u32x4*)src;
    }
#pragma unroll
    for (int i = 0; i < 2; ++i) {
      int e = tid + 256 * i, dv = e >> 3, part = e & 7;
      rv[i] = *(const u32x4*)(VT + ((size_t)((b * 4 + hd) * 64 + dv)) * NP + kt * 64 + part * 8);
    }
  };
  gload(0);
  for (int kt = 0; kt < nkt; ++kt) {
    __syncthreads();
#pragma unroll
    for (int i = 0; i < 3; ++i) {
      int e = tid + 256 * i, key = e / 12, part = e - key * 12;
      *(u32x4*)(Ks + key * 104 + part * 8) = rk[i];
    }
#pragma unroll
    for (int i = 0; i < 2; ++i) {
      int e = tid + 256 * i, dv = e >> 3, part = e & 7;
      *(u32x4*)(Vs + dv * 72 + part * 8) = rv[i];
    }
    __syncthreads();
    if (kt + 1 < nkt) gload(kt + 1);
    f32x16 sacc[2];
#pragma unroll
    for (int t = 0; t < 2; ++t) {
#pragma unroll
      for (int i = 0; i < 16; ++i) sacc[t][i] = 0.f;
#pragma unroll
      for (int s = 0; s < 6; ++s) {
        bf16x8 kf = *(const bf16x8*)(Ks + (t * 32 + r) * 104 + s * 16 + h * 8);
        sacc[t] = MFMA(kf, qf[s], sacc[t]);
      }
    }
    float mloc = sacc[0][0];
#pragma unroll
    for (int i = 1; i < 16; ++i) mloc = fmaxf(mloc, sacc[0][i]);
#pragma unroll
    for (int i = 0; i < 16; ++i) mloc = fmaxf(mloc, sacc[1][i]);
    mloc = fmaxf(mloc, __shfl_xor(mloc, 32, 64));
    float mnew = fmaxf(m, mloc);
    float alpha = __builtin_amdgcn_exp2f(m - mnew);
    m = mnew;
    float ls = 0.f;
#pragma unroll
    for (int t = 0; t < 2; ++t)
#pragma unroll
      for (int i = 0; i < 16; ++i) { float e = __builtin_amdgcn_exp2f(sacc[t][i] - mnew); sacc[t][i] = e; ls += e; }
    lsum = lsum * alpha + ls;
#pragma unroll
    for (int t = 0; t < 2; ++t)
#pragma unroll
      for (int i = 0; i < 16; ++i) oacc[t][i] *= alpha;
#pragma unroll
    for (int s4 = 0; s4 < 4; ++s4) {
      const int t2 = s4 >> 1, ss = s4 & 1;
      u32x4 pk;
#pragma unroll
      for (int q = 0; q < 4; ++q) pk[q] = pack2(sacc[t2][8 * ss + 2 * q], sacc[t2][8 * ss + 2 * q + 1]);
      bf16x8 pf = __builtin_bit_cast(bf16x8, pk);
#pragma unroll
      for (int dt = 0; dt < 2; ++dt) {
        const u16* vp = Vs + (dt * 32 + r) * 72 + t2 * 32 + 16 * ss + 4 * h;
        u32x2 lo = *(const u32x2*)(vp);
        u32x2 hi = *(const u32x2*)(vp + 8);
        u32x4 vv; vv[0] = lo[0]; vv[1] = lo[1]; vv[2] = hi[0]; vv[3] = hi[1];
        oacc[dt] = MFMA(__builtin_bit_cast(bf16x8, vv), pf, oacc[dt]);
      }
    }
  }
  lsum += __shfl_xor(lsum, 32, 64);
  const float inv = 1.f / lsum;
#pragma unroll
  for (int dt = 0; dt < 2; ++dt)
#pragma unroll
    for (int q = 0; q < 4; ++q) {
      u32x2 o;
      o[0] = pack2(oacc[dt][4 * q] * inv, oacc[dt][4 * q + 1] * inv);
      o[1] = pack2(oacc[dt][4 * q + 2] * inv, oacc[dt][4 * q + 3] * inv);
      *(u32x2*)(Ycat + gq * DM + 768 + hd * 64 + dt * 32 + 8 * q + 4 * h) = o;
    }
}

DI void scan_attn_phase(const Params& p, int l, char* smem) {
  for (int rep = 0; rep < opaque_s(PROBE == 2 ? 2 : 1); ++rep)
    for (int item = blockIdx.x; item < 256; item += gridDim.x) scan_item(p, item, smem);
  const int nattn = (l == 0) ? 1024 + 128 : 1024;
  const int NT = NTOK / 32;
  const int nitems = nattn + 2 * NT;
  unsigned* cnt = (unsigned*)(p.ws + WS_CNT) + l;
  int* sh = (int*)(smem + SMEM_BYTES - 16);
  while (true) {
    __syncthreads();
    if (TIDX == 0) *sh = (int)atomicAdd(cnt, 1u);
    __syncthreads();
    int item = *sh;
    if (item >= nitems) break;
    if (item < nattn) { attn_item(p, item, smem); continue; }
    int x = item - nattn;
    int task = x / NT, tile = x - task * NT;
    if (l == 1 && (tile % 72) < 8) continue;
    if (task == 0) prep_conv(p, l, tile, smem);
    else prep_pool(p, l, tile, smem);
  }
}

DI void rwkv_post_phase(const Params& p, int l) {
  const int lane = TIDX & 63, wave = TIDX >> 6;
  const int gwv = blockIdx.x * 4 + wave, nw = gridDim.x * 4;
  const u16* SV = (const u16*)(p.ws + WS_BIG + BIG_SV);
  const float* BONUS = (const float*)(p.ws + WS_BONUS);
  u16* Ycat = (u16*)(p.ws + WS_H);
  const int first = (l == 1) ? CL : 0, per_b = NP - first;
  const int total = NB * per_b * 4;
  for (int base = gwv * 4; base < total; base += nw * 4) {
    float y[4], bn[4], sv[4], gt[4];
    int gi[4], ci[4];
#pragma unroll
    for (int k = 0; k < 4; ++k) {
      int idx = base + k;
      int tk = idx >> 2, hd = idx & 3;
      int b = tk / per_b, pos = first + (tk - b * per_b);
      int g = b * NP + pos, c = hd * 64 + lane;
      gi[k] = g; ci[k] = c;
      y[k] = yrow(p.ws, (size_t)g, 0)[c] + yrow(p.ws, (size_t)g, 1)[c];
      bn[k] = BONUS[(size_t)g * 4 + hd] + BONUS[(size_t)NTOK * 4 + (size_t)g * 4 + hd];
      sv[k] = bf2f(SV[(size_t)g * 256 + c]);
      gt[k] = bf2f(Ycat[(size_t)g * DM + 256 + c]);
    }
#pragma unroll
    for (int k = 0; k < 4; ++k) {
      float mean = wsum(y[k]) * (1.f / 64.f);
      float d = y[k] - mean;
      float var = wsum(d * d) * (1.f / 64.f);
      float o = d * rsqrtf(var + 64e-5f) * IN(27)[l * 256 + ci[k]] + IN(28)[l * 256 + ci[k]];
      o = (o + bn[k] * sv[k]) * gt[k];
      Ycat[(size_t)gi[k] * DM + 256 + ci[k]] = f2bf(o);
    }
  }
}

#define XB_TMO      128
#define XB_XCNT(j)  (256  + 64 * (j))
#define XB_XSUB(j)  (1280 + 64 * (j))
#define XB_XGEN(j)  (2304 + 64 * (j))
#define XB_TOP      3328
#define XB_TOPGEN   3392
#define XCD_BAR_WORDS 3456
#define XB_SPIN_CAP (1u << 18)
#define LAS __attribute__((address_space(3)))
DI unsigned xb_ld(unsigned* p)              { return __hip_atomic_load(p, __ATOMIC_RELAXED, __HIP_MEMORY_SCOPE_AGENT); }
DI unsigned xb_add(unsigned* p, unsigned v) { return __hip_atomic_fetch_add(p, v, __ATOMIC_RELAXED, __HIP_MEMORY_SCOPE_AGENT); }
DI unsigned xb_xcc_id() { return (unsigned)__builtin_amdgcn_s_getreg((3 << 11) | 20) & 0xFu; }
#define XB_SPIN(cond, bar) do { unsigned _sp = 0; while (cond) { __builtin_amdgcn_s_sleep(1); \
    if ((++_sp & 255u) == 0u) { if (xb_ld(&(bar)[XB_TMO])) break; if (_sp > XB_SPIN_CAP) { atomicAdd(&(bar)[XB_TMO], 1u); break; } } } } while (0)
struct XcdBarrier { unsigned* bar; unsigned x; volatile LAS unsigned* st; int tid; };
DI XcdBarrier xcd_barrier_post(unsigned* bar, volatile LAS unsigned* st, int tid) {
  XcdBarrier b; b.bar = bar; b.x = xb_xcc_id(); b.st = st; b.tid = tid;
  if (tid == 0) (void)xb_add(&bar[XB_XCNT(b.x)], 1u);
  return b;
}
DI void xcd_barrier_complete(unsigned* bar, unsigned x, unsigned& nloc, unsigned& nx) {
  const unsigned G = gridDim.x * gridDim.y * gridDim.z;
  unsigned sum, cnt, mine, sp = 0u;
  for (;;) {
    sum = 0u; cnt = 0u; mine = 0u;
#pragma unroll
    for (unsigned j = 0; j < 16; ++j) { const unsigned c = xb_ld(&bar[XB_XCNT(j)]); sum += c; cnt += (c > 0u) ? 1u : 0u; mine = (j == x) ? c : mine; }
    if (sum == G) break;
    __builtin_amdgcn_s_sleep(1);
    if ((++sp & 255u) == 0u) { if (xb_ld(&bar[XB_TMO])) break; if (sp > XB_SPIN_CAP) { atomicAdd(&bar[XB_TMO], 1u); break; } }
  }
  nloc = mine > 0u ? mine : 1u; nx = cnt > 0u ? cnt : 1u;
}
DI void xcd_barrier(const XcdBarrier& b) {
  asm volatile("s_waitcnt vmcnt(0)" ::: "memory");
  __syncthreads();
  if (b.tid == 0) {
    unsigned* bar = b.bar;
    __builtin_amdgcn_s_waitcnt(0);
    unsigned nloc = b.st[0], nx = b.st[1];
    if (nloc == 0u) { xcd_barrier_complete(bar, b.x, nloc, nx); b.st[0] = nloc; b.st[1] = nx; }
    const unsigned old = xb_add(&bar[XB_XSUB(b.x)], 1u);
    const unsigned gen = old / nloc;
    if (old + 1u == (gen + 1u) * nloc) {
      __builtin_amdgcn_fence(__ATOMIC_RELEASE, "agent");
      asm volatile("s_waitcnt vmcnt(0)" ::: "memory");
      const unsigned og = xb_add(&bar[XB_TOP], 1u);
      const unsigned tg = og / nx;
      if (og + 1u == (tg + 1u) * nx) xb_add(&bar[XB_TOPGEN], 1u);
      else XB_SPIN(xb_ld(&bar[XB_TOPGEN]) == tg, bar);
      __builtin_amdgcn_fence(__ATOMIC_ACQUIRE, "agent");
      xb_add(&bar[XB_XGEN(b.x)], 1u);
      asm volatile("s_waitcnt vmcnt(0)" ::: "memory");
    } else {
      XB_SPIN(xb_ld(&bar[XB_XGEN(b.x)]) == gen, bar);
      __builtin_amdgcn_fence(__ATOMIC_ACQUIRE, "agent");
      asm volatile("s_waitcnt vmcnt(0)" ::: "memory");
    }
  }
  __syncthreads();
}

DI void write_table(const Params& p) {
  const float** tab = (const float**)(p.ws + WS_TAB);
#define TB(i) tab[i] = p.in[i];
  TB(0) TB(1) TB(2) TB(3) TB(4) TB(5) TB(6) TB(7) TB(8) TB(9) TB(10) TB(11) TB(12) TB(13) TB(14) TB(15) TB(16) TB(17)
  TB(18) TB(19) TB(20) TB(21) TB(22) TB(23) TB(24) TB(25) TB(26) TB(27) TB(28) TB(29) TB(30) TB(31) TB(32) TB(33) TB(34) TB(35)
#undef TB
}

#define PHASE(k, ...) { if (ph_lo <= (k) && (k) < ph_hi) { if ((k) > ph_lo) { xcd_barrier(xb); } for (int rep_ = 0; rep_ < opaque_s((PROBE - 100 == (k)) ? 2 : 1); ++rep_) { __VA_ARGS__; } } }
template <int L>
DI void layer_phases(const Params& p, cg::grid_group& grid, const XcdBarrier& xb, char* smem, int ph_lo, int ph_hi) {
  const u16* wt = (const u16*)(p.ws + WS_WT);
  const u16* H = (const u16*)(p.ws + WS_H);
  constexpr bool last = (L == 1);
  constexpr int base = 1 + 9 * L;
  PHASE(base + 0, {
    if (L == 1) for (int item = blockIdx.x; item < N_CONV_TILES; item += gridDim.x) convert_item<false>(p, 1, item, smem);
    norm_phase(p, L, IN(6) + L * 1024, 0, 1, L == 0, false);
  })
  PHASE(base + 1, (gemm_phase<4, 0>(p, H, DM, wt + WT_WIN, 1024, PINP / 128, smem, L, 0, false, false)))
  PHASE(base + 2, {
    for (int rep = 0; rep < opaque_s(PROBE == 3 ? 2 : 1); ++rep) prep_phase(p, L, smem);
  })
  PHASE(base + 3, scan_attn_phase(p, L, smem))
  PHASE(base + 4, rwkv_post_phase(p, L))
  PHASE(base + 5, (gemm_phase<2, 1>(p, H, DM, wt + WT_WOUT, 1024, 8, smem, L, 2, L == 0, last)))
  PHASE(base + 6, norm_phase(p, L, IN(7) + L * 1024, 3, 4, false, last))
  PHASE(base + 7, {
    for (int rep = 0; rep < opaque_s(PROBE == 1 ? 2 : 1); ++rep) gemm_phase<4, 2>(p, H, DM, wt + WT_W1, 1024, 32, smem, L, 0, false, last);
  })
  PHASE(base + 8, (gemm_phase<2, 1>(p, (const u16*)(p.ws + WS_BIG), DFF, wt + WT_W2, 4096, 8, smem, L, 5, false, last)))
}

__global__ void __launch_bounds__(256, 2) mega(Params p_, int ph_lo, int ph_hi) {
  __shared__ __attribute__((aligned(16))) char smem[SMEM_BYTES];
  __shared__ uint4 xb_words;
  cg::grid_group grid = cg::this_grid();
  if (ph_hi > 1000) grid.sync();
  Params p = p_;
  p.wave64 = __builtin_amdgcn_readfirstlane((int)threadIdx.x) & ~63;
  const int tid_ = TIDX;
  if (tid_ == 0) xb_words = make_uint4(0u, 0u, 0u, 0u);
  __syncthreads();
  const XcdBarrier xb = xcd_barrier_post((unsigned*)(p.ws + WS_BAR), (volatile LAS unsigned*)&xb_words, tid_);
  PHASE(0, {
    if (blockIdx.x == 0 && tid_ == 0) {
      unsigned* cn = (unsigned*)(p.ws + WS_CNT);
      cn[0] = 0u; cn[1] = 0u; cn[2] = 0u; cn[3] = 0u;
      write_table(p);
    }
    for (int item = blockIdx.x; item < 192 + N_CONV_TILES; item += gridDim.x) {
      if (item < 192) mod_item(p, item, smem);
      else convert_item<true>(p, 0, item - 192, smem);
    }
  })
  layer_phases<0>(p, grid, xb, smem, ph_lo, ph_hi);
  layer_phases<1>(p, grid, xb, smem, ph_lo, ph_hi);
  PHASE(19, final_norm_phase(p))
}

extern "C" void kernel_launch(void* const* d_in, const int* in_sizes, int n_in, void* d_out, int out_size, void* d_ws,
                              size_t ws_size, hipStream_t stream) {
  if (ws_size < WS_TOTAL) { fprintf(stderr, "workspace too small: %zu < %zu\n", ws_size, (size_t)WS_TOTAL); return; }
  static int grid_blocks = 0;
  if (!grid_blocks) {
    int dev = 0, cus = 0, per_cu = 0;
    hipGetDevice(&dev);
    hipDeviceGetAttribute(&cus, hipDeviceAttributeMultiprocessorCount, dev);
    hipOccupancyMaxActiveBlocksPerMultiprocessor(&per_cu, mega, 256, 0);
    if (per_cu > 2) per_cu = 2;
    if (per_cu < 1) per_cu = 1;
    grid_blocks = cus * per_cu;
  }
  Params p{};
  for (int i = 0; i < 36; ++i) p.in[i] = (const float*)d_in[i];
  p.out = (float*)d_out;
  p.ws = (char*)d_ws;
  p.wave64 = 0;
  p.pad_ = 0;
  hipMemsetAsync((char*)d_ws + WS_BAR, 0, XCD_BAR_WORDS * 4, stream);
  int lo = 0, hi = 20;
  void* args[] = {&p, &lo, &hi};
  hipError_t e = hipLaunchCooperativeKernel((void*)mega, dim3(grid_blocks), dim3(256), args, 0, stream);
  if (e != hipSuccess) fprintf(stderr, "cooperative launch failed: %s (grid %d)\n", hipGetErrorString(e), grid_blocks);
}
```

```cpp
#include <hip/hip_runtime.h>
#include <hip/hip_cooperative_groups.h>
#include <cstdio>
namespace cg = cooperative_groups;

#define DI __device__ __forceinline__
typedef unsigned short u16;
typedef __attribute__((ext_vector_type(8))) short bf16x8;
typedef __attribute__((ext_vector_type(16))) float f32x16;
typedef __attribute__((ext_vector_type(4))) unsigned u32x4;
typedef __attribute__((ext_vector_type(2))) unsigned u32x2;
typedef float f2 __attribute__((ext_vector_type(2)));
#define MFMA(a, b, c) __builtin_amdgcn_mfma_f32_32x32x16_bf16((a), (b), (c), 0, 0, 0)

constexpr int NB = 16, TL = 2048, CL = 256, NP = 2304, NTOK = NB * NP, DM = 1024;
constexpr int PIN = 2336, PINP = 2432, DFF = 4096;
constexpr int OFF_POOL = 512, OFF_Q = 768, OFF_RW = 1024, OFF_KV = 2176;

constexpr size_t WT_WIN = 0;
constexpr size_t WT_WOUT = WT_WIN + (size_t)PINP * 1024;
constexpr size_t WT_W1 = WT_WOUT + 1024 * 1024;
constexpr size_t WT_W2 = WT_W1 + 4096 * 1024;
constexpr size_t WT_PW = WT_W2 + 4096 * 1024;
constexpr size_t WT_WUQ = WT_PW + 256 * 256;
constexpr size_t WT_WUKV = WT_WUQ + 384 * 256;
constexpr size_t WT_POOL = WT_WUKV + 512 * 128;
constexpr size_t WT_RW2 = WT_POOL + 4 * 64 * 64;
constexpr size_t WT_RA2 = WT_RW2 + 2 * 256 * 64;
constexpr size_t WT_RG2 = WT_RA2 + 2 * 256 * 64;
constexpr size_t WT_END = WT_RG2 + 256 * 128;
constexpr size_t WS_WT = 0;
constexpr size_t WS_MOD = WS_WT + WT_END * 2;
constexpr size_t WS_XCTX = WS_MOD + (size_t)2 * 17 * 6144 * 4;
constexpr size_t WS_BONUS = WS_XCTX + (size_t)NB * CL * DM * 4;
constexpr size_t WS_CNT = WS_BONUS + (size_t)2 * NTOK * 4 * 4;
constexpr size_t WS_TAB = WS_CNT + 256;
constexpr size_t WS_BAR = WS_TAB + 512;
constexpr size_t WS_H = WS_BAR + 3456 * 4;
constexpr size_t WS_BIG = WS_H + (size_t)NTOK * DM * 2;
constexpr size_t SZ_TOK256 = (size_t)NTOK * 256 * 2;
constexpr size_t BIG_P = 0;
constexpr size_t BIG_Q = BIG_P + (size_t)NTOK * PIN * 2;
constexpr size_t BIG_KN = BIG_Q + (size_t)NTOK * 384 * 2;
constexpr size_t BIG_KR = BIG_KN + SZ_TOK256;
constexpr size_t BIG_VT = BIG_KR + (size_t)NTOK * 32 * 2;
constexpr size_t BIG_SR = BIG_VT + SZ_TOK256;
constexpr size_t BIG_SKK = BIG_SR + SZ_TOK256;
constexpr size_t BIG_SV = BIG_SKK + SZ_TOK256;
constexpr size_t BIG_SDEC = BIG_SV + SZ_TOK256;
constexpr size_t BIG_SKD = BIG_SDEC + 2 * SZ_TOK256;
constexpr size_t BIG_SB = BIG_SKD + 2 * SZ_TOK256;
constexpr size_t BIG_END = BIG_SB + 2 * SZ_TOK256;
DI float* yrow(char* ws, size_t g, int d) { return (float*)(ws + WS_BIG + BIG_P + g * (size_t)(PIN * 2) + OFF_RW * 2 + d * 1024); }
constexpr size_t WS_TOTAL = WS_BIG + BIG_END;
static_assert((size_t)NTOK * DFF * 2 <= BIG_END, "Hff must fit");

constexpr int SMEM_BYTES = 59392;
#ifndef PROBE
#define PROBE 0
#endif

struct Params {
  const float* in[36];
  float* out;
  char* ws;
  int wave64;
  int pad_;
};

DI u16 f2bf(float x) {
  unsigned u = __float_as_uint(x);
  u += 0x7fffu + ((u >> 16) & 1u);
  return (u16)(u >> 16);
}
DI int lane_id_() { unsigned z = 0u; asm volatile("" : "+v"(z)); return (int)__builtin_amdgcn_mbcnt_hi(~0u, __builtin_amdgcn_mbcnt_lo(~0u, z)); }
#define TIDX (p.wave64 + lane_id_())
DI int opaque(int x) { asm volatile("" : "+v"(x)); return x; }
struct PW { char* ws; float* out; int wave64; };
DI char* opaque_p(char* x) { asm volatile("" : "+s"(x)); return x; }
DI int opaque_s(int x) { asm volatile("" : "+s"(x)); return x; }
DI float bf2f(u16 v) { return __uint_as_float(((unsigned)v) << 16); }
DI unsigned pack2(float a, float b) { return (unsigned)f2bf(a) | ((unsigned)f2bf(b) << 16); }
DI float bflo(unsigned u) { return __uint_as_float(u << 16); }
DI float bfhi(unsigned u) { return __uint_as_float(u & 0xffff0000u); }
DI float sigm(float x) { return 1.f / (1.f + __expf(-x)); }
DI int crow(int i, int h) { return (i & 3) + 8 * (i >> 2) + 4 * h; }
DI float dpp_f(float v, int ctrl_sel) {
  int x = __float_as_int(v);
  int r;
  if (ctrl_sel == 0) r = __builtin_amdgcn_update_dpp(0, x, 0xB1, 0xf, 0xf, true);
  else if (ctrl_sel == 1) r = __builtin_amdgcn_update_dpp(0, x, 0x4E, 0xf, 0xf, true);
  else r = __builtin_amdgcn_update_dpp(0, x, 0x141, 0xf, 0xf, true);
  return __int_as_float(r);
}
DI float sum8(float v) {
  v += dpp_f(v, 0);
  v += dpp_f(v, 1);
  v += dpp_f(v, 2);
  return v;
}

DI float wsum(float v) {
  v += dpp_f(v, 0);
  v += dpp_f(v, 1);
  v += dpp_f(v, 2);
  v += __int_as_float(__builtin_amdgcn_update_dpp(0, __float_as_int(v), 0x140, 0xf, 0xf, true));
  int x = __float_as_int(v);
  return (__int_as_float(__builtin_amdgcn_readlane(x, 0)) + __int_as_float(__builtin_amdgcn_readlane(x, 16))) +
         (__int_as_float(__builtin_amdgcn_readlane(x, 32)) + __int_as_float(__builtin_amdgcn_readlane(x, 48)));
}

DI const float* inp(const char* ws, int i) {
  unsigned long long v = ((const unsigned long long*)(ws + WS_TAB))[i];
  unsigned lo = __builtin_amdgcn_readfirstlane((unsigned)v), hi = __builtin_amdgcn_readfirstlane((unsigned)(v >> 32));
  return (const float*)(((unsigned long long)hi << 32) | (unsigned long long)lo);
}
#define IN(i) inp(p.ws, (i))
template <class PT>
DI const float* xsrc_row(const PT& p, bool from_input, int g) {
  int b = g / NP, pos = g - b * NP;
  if (pos < CL) return (from_input ? IN(2) : (const float*)(p.ws + WS_XCTX)) + ((size_t)(b * CL + pos)) * DM;
  return (from_input ? IN(0) : (const float*)p.out) + ((size_t)(b * TL + pos - CL)) * DM;
}
template <class PT>
DI float* xdst_row(const PT& p, int g) {
  int b = g / NP, pos = g - b * NP;
  if (pos < CL) return (float*)(p.ws + WS_XCTX) + ((size_t)(b * CL + pos)) * DM;
  return p.out + ((size_t)(b * TL + pos - CL)) * DM;
}

template <bool DIRECT>
DI void wdesc(const Params& p, int l, int i, const float*& src, u16*& dst, int& K, int& N, int& Npad) {
#define WIN(k) (DIRECT ? p.in[k] : IN(k))
  u16* wt = (u16*)(p.ws + WS_WT);
  if (i == 0) { src = WIN(8) + (size_t)l * 1024 * PIN; dst = wt + WT_WIN; K = 1024; N = PIN; Npad = PINP; }
  else if (i == 1) { src = WIN(9) + (size_t)l * 1024 * 1024; dst = wt + WT_WOUT; K = 1024; N = 1024; Npad = 1024; }
  else if (i == 2) { src = WIN(33) + (size_t)l * 1024 * 4096; dst = wt + WT_W1; K = 1024; N = 4096; Npad = 4096; }
  else if (i == 3) { src = WIN(34) + (size_t)l * 4096 * 1024; dst = wt + WT_W2; K = 4096; N = 1024; Npad = 1024; }
  else if (i == 4) { src = WIN(14) + (size_t)l * 65536; dst = wt + WT_PW; K = 256; N = 256; Npad = 256; }
  else if (i == 5) { src = WIN(30) + (size_t)l * 256 * 384; dst = wt + WT_WUQ; K = 256; N = 384; Npad = 384; }
  else if (i == 6) { src = WIN(32) + (size_t)l * 128 * 512; dst = wt + WT_WUKV; K = 128; N = 512; Npad = 512; }
  else if (i < 11) { src = WIN(15) + (size_t)l * 16384 + (i - 7) * 4096; dst = wt + WT_POOL + (i - 7) * 4096; K = 64; N = 64; Npad = 64; }
  else if (i < 13) { src = WIN(20) + (size_t)l * 32768 + (i - 11) * 16384; dst = wt + WT_RW2 + (i - 11) * 16384; K = 64; N = 256; Npad = 256; }
  else if (i < 15) { src = WIN(22) + (size_t)l * 32768 + (i - 13) * 16384; dst = wt + WT_RA2 + (i - 13) * 16384; K = 64; N = 256; Npad = 256; }
  else { src = WIN(23) + (size_t)l * 32768; dst = wt + WT_RG2; K = 128; N = 256; Npad = 256; }
}
#undef WIN

DI void convert_tile(const float* __restrict__ src, u16* __restrict__ dst, int K, int N, int k0, int n0, char* smem, int tid_in) {
  float* tile = (float*)smem;
  const int tid = opaque(tid_in);
  __syncthreads();
#pragma unroll
  for (int i = 0; i < 16; ++i) {
    int e = tid + 256 * i, kk = e >> 6, nn = e & 63;
    float v = 0.f;
    if (n0 + nn < N) v = src[(size_t)(k0 + kk) * N + n0 + nn];
    tile[kk * 65 + nn] = v;
  }
  __syncthreads();
#pragma unroll
  for (int i = 0; i < 8; ++i) {
    int e = tid + 256 * i, nn = e >> 5, kp = e & 31;
    unsigned v = pack2(tile[(2 * kp) * 65 + nn], tile[(2 * kp + 1) * 65 + nn]);
    *(unsigned*)(dst + (size_t)(n0 + nn) * K + k0 + 2 * kp) = v;
  }
}

constexpr int N_CONV_TILES = 2996;
template <bool DIRECT>
DI void convert_item(const Params& p, int l, int item, char* smem) {
  int acc = 0;
  for (int i = 0; i < 16; ++i) {
    const float* src; u16* dst; int K, N, Npad;
    wdesc<DIRECT>(p, l, i, src, dst, K, N, Npad);
    int tn = Npad >> 6, cnt = (K >> 6) * tn;
    if (item < acc + cnt) {
      int t = item - acc;
      convert_tile(src, dst, K, N, (t / tn) * 64, (t % tn) * 64, smem, TIDX);
      return;
    }
    acc += cnt;
  }
}

DI void mod_item(const Params& p, int item, char* smem) {
  const int l = item / 96, cb = item % 96;
  const int tid = opaque(TIDX), cq = tid & 15, kg = tid >> 4, lane = tid & 63, wave = tid >> 6;
  float* sl = (float*)smem;
  float* red = (float*)(smem + 34816);
  const float* W = p.in[4] + (size_t)l * 1024 * 6144;
  const int col = cb * 64 + cq * 4;
  float acc[17][4];
#pragma unroll
  for (int b = 0; b < 17; ++b) { acc[b][0] = acc[b][1] = acc[b][2] = acc[b][3] = 0.f; }
  for (int half = 0; half < 2; ++half) {
    __syncthreads();
    for (int e = tid; e < 17 * 512; e += 256) {
      int b = e >> 9, k = e & 511;
      float cv = (b < 16) ? p.in[1][b * 1024 + half * 512 + k] : p.in[3][half * 512 + k];
      sl[e] = cv * sigm(cv);
    }
    __syncthreads();
#pragma unroll 8
    for (int kk = 0; kk < 32; ++kk) {
      int kl = kg * 32 + kk;
      float4 w = *(const float4*)(W + (size_t)(half * 512 + kl) * 6144 + col);
#pragma unroll
      for (int b = 0; b < 17; ++b) {
        float s = sl[b * 512 + kl];
        acc[b][0] += s * w.x; acc[b][1] += s * w.y; acc[b][2] += s * w.z; acc[b][3] += s * w.w;
      }
    }
  }
#pragma unroll
  for (int b = 0; b < 17; ++b)
#pragma unroll
    for (int j = 0; j < 4; ++j) {
      float v = acc[b][j];
      v += __shfl_xor(v, 16, 64);
      v += __shfl_xor(v, 32, 64);
      acc[b][j] = v;
    }
  __syncthreads();
  if (lane < 16) {
#pragma unroll
    for (int b = 0; b < 17; ++b)
#pragma unroll
      for (int j = 0; j < 4; ++j) red[(wave * 17 + b) * 64 + cq * 4 + j] = acc[b][j];
  }
  __syncthreads();
  float* mod = (float*)(p.ws + WS_MOD) + (size_t)l * 17 * 6144;
  for (int e = tid; e < 17 * 64; e += 256) {
    int b = e >> 6, cc = e & 63;
    float v = red[(0 * 17 + b) * 64 + cc] + red[(1 * 17 + b) * 64 + cc] + red[(2 * 17 + b) * 64 + cc] + red[(3 * 17 + b) * 64 + cc];
    mod[b * 6144 + cb * 64 + cc] = v + p.in[5][l * 6144 + cb * 64 + cc];
  }
}

DI void norm_phase(const Params& p, int l, const float* gw, int isft, int isc, bool from_input, bool skip_ctx) {
  const int lane = TIDX & 63, wave = TIDX >> 6;
  const int gwv = blockIdx.x * 4 + wave, nw = gridDim.x * 4;
  u16* H = (u16*)(p.ws + WS_H);
  const float* mod = (const float*)(p.ws + WS_MOD) + (size_t)l * 17 * 6144;
  const int first = skip_ctx ? CL : 0, per_b = NP - first, total = NB * per_b;
  constexpr int RB = 4;
  for (int base = gwv; base < total; base += nw * RB) {
    float4 v[RB][4];
    int gi[RB];
#pragma unroll
    for (int k = 0; k < RB; ++k) {
      int idx = min(base + k * nw, total - 1);
      int b = idx / per_b, pos = first + (idx - b * per_b);
      gi[k] = b * NP + pos;
      const float* x = xsrc_row(p, from_input, gi[k]);
#pragma unroll
      for (int i = 0; i < 4; ++i) v[k][i] = *(const float4*)(x + lane * 4 + 256 * i);
    }
#pragma unroll
    for (int k = 0; k < RB; ++k) {
      if (base + k * nw >= total) break;
      const int g = gi[k];
      const int b = g / NP, pos = g - b * NP;
      const float* mrow = mod + (size_t)(pos < CL ? 16 : b) * 6144;
      float ss = 0.f;
#pragma unroll
      for (int i = 0; i < 4; ++i) ss += v[k][i].x * v[k][i].x + v[k][i].y * v[k][i].y + v[k][i].z * v[k][i].z + v[k][i].w * v[k][i].w;
      ss = wsum(ss);
      float rs = rsqrtf(ss * (1.f / 1024.f) + 1e-6f);
#pragma unroll
      for (int i = 0; i < 4; ++i) {
        int c = lane * 4 + 256 * i;
        float4 gg = *(const float4*)(gw + c);
        float4 sc = *(const float4*)(mrow + isc * 1024 + c);
        float4 sf = *(const float4*)(mrow + isft * 1024 + c);
        float a0 = v[k][i].x * rs * gg.x * (1.f + sc.x) + sf.x;
        float a1 = v[k][i].y * rs * gg.y * (1.f + sc.y) + sf.y;
        float a2 = v[k][i].z * rs * gg.z * (1.f + sc.z) + sf.z;
        float a3 = v[k][i].w * rs * gg.w * (1.f + sc.w) + sf.w;
        u32x2 o; o[0] = pack2(a0, a1); o[1] = pack2(a2, a3);
        *(u32x2*)(H + (size_t)g * DM + c) = o;
      }
    }
  }
}

DI void final_norm_phase(const Params& p) {
  const int lane = TIDX & 63, wave = TIDX >> 6;
  const int gwv = blockIdx.x * 4 + wave, nw = gridDim.x * 4;
  const float* gw = IN(35);
  constexpr int RB = 4;
  const int total = NB * TL;
  for (int base = gwv; base < total; base += nw * RB) {
    float4 v[RB][4];
#pragma unroll
    for (int k = 0; k < RB; ++k) {
      int row = min(base + k * nw, total - 1);
      const float* x = p.out + (size_t)row * DM;
#pragma unroll
      for (int i = 0; i < 4; ++i) v[k][i] = *(const float4*)(x + lane * 4 + 256 * i);
    }
#pragma unroll
    for (int k = 0; k < RB; ++k) {
      int row = base + k * nw;
      if (row >= total) break;
      float* x = p.out + (size_t)row * DM;
      float ss = 0.f;
#pragma unroll
      for (int i = 0; i < 4; ++i) ss += v[k][i].x * v[k][i].x + v[k][i].y * v[k][i].y + v[k][i].z * v[k][i].z + v[k][i].w * v[k][i].w;
      ss = wsum(ss);
      float rs = rsqrtf(ss * (1.f / 1024.f) + 1e-6f);
#pragma unroll
      for (int i = 0; i < 4; ++i) {
        int c = lane * 4 + 256 * i;
        float4 gg = *(const float4*)(gw + c);
        float4 o;
        o.x = v[k][i].x * rs * gg.x; o.y = v[k][i].y * rs * gg.y; o.z = v[k][i].z * rs * gg.z; o.w = v[k][i].w * rs * gg.w;
        *(float4*)(x + c) = o;
      }
    }
  }
}

template <int MT, int EPI>
DI void gemm_tile(const Params& pp, const u16* __restrict__ A, int lda, const u16* __restrict__ Bt, int K,
                          int m0, int n0, char* smem, int l, int modidx, bool from_input) {
  const PW p = {opaque_p(pp.ws), pp.out, pp.wave64};
  constexpr int BM = 64 * MT;
  constexpr int LS = 72;
  constexpr int NR = (MT == 2) ? 2 : 1;
  u16* As = (u16*)smem;
  u16* Bs = As + BM * LS;
  const int tid = opaque(TIDX), lane = tid & 63, wave = tid >> 6;
  const int wm = wave >> 1, wn = wave & 1, r = lane & 31, h = lane >> 5;
  f32x16 acc[MT][2];
#pragma unroll
  for (int a = 0; a < MT; ++a)
#pragma unroll
    for (int b = 0; b < 2; ++b)
#pragma unroll
      for (int i = 0; i < 16; ++i) acc[a][b][i] = 0.f;
  u32x4 ra[NR][2 * MT], rb[NR][4];
  const int nk = K >> 6;
  const int lrow = tid >> 3, lkc = tid & 7;
  const char* Abase = (const char*)(A + (size_t)m0 * lda);
  const char* Bbase = (const char*)(Bt + (size_t)n0 * K);
  const unsigned voffA = (unsigned)(lrow * lda + lkc * 8) * 2u;
  const unsigned voffB = (unsigned)(lrow * K + lkc * 8) * 2u;
  const unsigned lds_w = (unsigned)(lrow * LS + lkc * 8);
#define GL(set, kt_)                                                                                      \
  {                                                                                                       \
    _Pragma("unroll") for (int i = 0; i < 2 * MT; ++i)                                                    \
        ra[set][i] = *(const u32x4*)(Abase + ((size_t)(32 * i) * lda + (size_t)(kt_) * 64) * 2 + voffA);  \
    _Pragma("unroll") for (int i = 0; i < 4; ++i)                                                         \
        rb[set][i] = *(const u32x4*)(Bbase + ((size_t)(32 * i) * K + (size_t)(kt_) * 64) * 2 + voffB);    \
  }
  if (MT == 2) {
    GL(0, 0)
    if (nk > 1) GL(1, 1)
    __syncthreads();
#pragma unroll
    for (int i = 0; i < 2 * MT; ++i) *(u32x4*)(As + lds_w + 32 * i * LS) = ra[0][i];
#pragma unroll
    for (int i = 0; i < 4; ++i) *(u32x4*)(Bs + lds_w + 32 * i * LS) = rb[0][i];
    if (nk > 2) GL(0, 2)
    __syncthreads();
    for (int kt = 0; kt < nk; kt += 2) {
#pragma unroll
      for (int s = 0; s < 2; ++s) {
        bf16x8 af[4][MT], bfr[4][2];
#pragma unroll
        for (int ks = 0; ks < 4; ++ks) {
#pragma unroll
          for (int a = 0; a < MT; ++a) af[ks][a] = *(const bf16x8*)(As + (wm * 32 * MT + a * 32 + r) * LS + ks * 16 + h * 8);
#pragma unroll
          for (int b = 0; b < 2; ++b) bfr[ks][b] = *(const bf16x8*)(Bs + (wn * 64 + b * 32 + r) * LS + ks * 16 + h * 8);
        }
        __syncthreads();
        if (kt + s + 1 < nk) {
#pragma unroll
          for (int i = 0; i < 2 * MT; ++i) *(u32x4*)(As + lds_w + 32 * i * LS) = ra[(s + 1) & 1][i];
#pragma unroll
          for (int i = 0; i < 4; ++i) *(u32x4*)(Bs + lds_w + 32 * i * LS) = rb[(s + 1) & 1][i];
          if (kt + s + 3 < nk) GL((s + 1) & 1, kt + s + 3)
        }
#pragma unroll
        for (int ks = 0; ks < 4; ++ks)
#pragma unroll
          for (int a = 0; a < MT; ++a)
#pragma unroll
            for (int b = 0; b < 2; ++b) acc[a][b] = MFMA(af[ks][a], bfr[ks][b], acc[a][b]);
        __syncthreads();
      }
    }
  } else {
#pragma unroll
  for (int s = 0; s < NR; ++s) GL(s, s)
  for (int kt = 0; kt < nk; kt += NR) {

#pragma unroll
    for (int s = 0; s < NR; ++s) {
      __syncthreads();
#pragma unroll
      for (int i = 0; i < 2 * MT; ++i) *(u32x4*)(As + lds_w + 32 * i * LS) = ra[s][i];
#pragma unroll
      for (int i = 0; i < 4; ++i) *(u32x4*)(Bs + lds_w + 32 * i * LS) = rb[s][i];
      __syncthreads();
      if (kt + s + NR < nk) GL(s, kt + s + NR)
#pragma unroll
      for (int ks = 0; ks < 4; ++ks) {
        bf16x8 af[MT], bfr[2];
#pragma unroll
        for (int a = 0; a < MT; ++a) af[a] = *(const bf16x8*)(As + (wm * 32 * MT + a * 32 + r) * LS + ks * 16 + h * 8);
#pragma unroll
        for (int b = 0; b < 2; ++b) bfr[b] = *(const bf16x8*)(Bs + (wn * 64 + b * 32 + r) * LS + ks * 16 + h * 8);
#pragma unroll
        for (int a = 0; a < MT; ++a)
#pragma unroll
          for (int b = 0; b < 2; ++b) acc[a][b] = MFMA(af[a], bfr[b], acc[a][b]);
      }
    }
  }
  }
#undef GL
  if (EPI == 0 || EPI == 2) {
    constexpr int CS = 136;
    constexpr int NPASS = MT / 2;
    u16* Cs = (u16*)smem;
    u16* Cg = (EPI == 0) ? (u16*)(p.ws + WS_BIG + BIG_P) : (u16*)(p.ws + WS_BIG);
    const int ldc = (EPI == 0) ? PIN : DFF;
#pragma unroll
    for (int pass = 0; pass < NPASS; ++pass) {
      __syncthreads();
      if (NPASS == 1 || wm == pass) {
#pragma unroll
        for (int a = 0; a < MT; ++a)
#pragma unroll
          for (int b = 0; b < 2; ++b) {
            u16* cp = Cs + ((NPASS == 1 ? wm * 64 : 0) + a * 32 + 4 * h) * CS + wn * 64 + b * 32 + r;
#pragma unroll
            for (int i = 0; i < 16; ++i) {
              float v = acc[a][b][i];
              if (EPI == 2) { v = fmaxf(v, 0.f); v = v * v; }
              cp[(8 * (i >> 2) + (i & 3)) * CS] = f2bf(v);
            }
          }
      }
      __syncthreads();
#pragma unroll
      for (int i = 0; i < 8; ++i) {
        int e = tid + 256 * i, row = e >> 4, cc = e & 15;
        if (EPI == 2 || n0 + cc * 8 < PIN) {
          u32x4 v = *(const u32x4*)(Cs + row * CS + cc * 8);
          *(u32x4*)(Cg + (size_t)(m0 + pass * 128 + row) * ldc + n0 + cc * 8) = v;
        }
      }
    }
  } else if (EPI == 1) {
    const int bb = m0 / NP, pos0 = m0 - bb * NP;
    const float* src = xsrc_row(p, from_input, m0);
    float* dst = xdst_row(p, m0);
    const float* mrow = (const float*)(p.ws + WS_MOD) + (size_t)l * 17 * 6144 + (size_t)(pos0 < CL ? 16 : bb) * 6144 + modidx * 1024;
#pragma unroll
    for (int b = 0; b < 2; ++b) {
      int col = n0 + wn * 64 + b * 32 + r;
      float mv = mrow[col];
      float xv[MT][16];
#pragma unroll
      for (int a = 0; a < MT; ++a) {
        const float* sp = src + (size_t)(wm * 32 * MT + a * 32 + 4 * h) * DM + col;
#pragma unroll
        for (int i = 0; i < 16; ++i) xv[a][i] = sp[(size_t)(8 * (i >> 2) + (i & 3)) * DM];
      }
#pragma unroll
      for (int a = 0; a < MT; ++a) {
        float* dp = dst + (size_t)(wm * 32 * MT + a * 32 + 4 * h) * DM + col;
#pragma unroll
        for (int i = 0; i < 16; ++i) dp[(size_t)(8 * (i >> 2) + (i & 3)) * DM] = xv[a][i] + mv * acc[a][b][i];
      }
      __builtin_amdgcn_sched_barrier(0);
    }
  }
}

template <int MT, int EPI>
DI void gemm_phase(const Params& p, const u16* A, int lda, const u16* Bt, int K, int ntn, char* smem,
                           int l, int modidx, bool from_input, bool skip_ctx) {
  constexpr int BM = 64 * MT;
  constexpr int TPB = NP / BM;
  constexpr int CPB = CL / BM;
  const int ntm = skip_ctx ? NB * (TPB - CPB) : NB * TPB;
  if (blockIdx.x >= (gridDim.x >> 1)) __builtin_amdgcn_s_sleep(48);
  const int xcd = blockIdx.x & 7, jb = blockIdx.x >> 3, nbx = gridDim.x >> 3;
  const int msplit = (EPI == 1) ? 8 : 2, nsplit = 8 / msplit;
  const int mi = xcd / nsplit, ni = xcd % nsplit;
  const int mpx = ntm / msplit;
  const int nper = (ntn + nsplit - 1) / nsplit;
  const int nlo = ni * nper, nw = min(ntn, nlo + nper) - nlo;
  for (int t = jb; t < mpx * nw; t += nbx) {
    int mtc = mi * mpx + t / nw, nt = nlo + t % nw;
    int mt = skip_ctx ? (mtc / (TPB - CPB)) * TPB + CPB + (mtc % (TPB - CPB)) : mtc;
    int m0 = mt * BM;
    if (EPI == 0 && l == 1 && (m0 % NP) < CL && nt < 8) continue;
    gemm_tile<MT, EPI>(p, A, lda, Bt, K, m0, nt * 128, smem, l, modidx, from_input);
  }
}

template <int KK, int NT>
DI void small_gemm(const u16* As, int lda, const u16* __restrict__ Bt, int ldb, int n0, f32x16* acc) {
  const int lane = lane_id_(), r = lane & 31, h = lane >> 5;
#pragma unroll
  for (int t = 0; t < NT; ++t)
#pragma unroll
    for (int i = 0; i < 16; ++i) acc[t][i] = 0.f;
  const u16* bp = Bt + (size_t)(n0 + r) * ldb + h * 8;
  const u16* ap = As + r * lda + h * 8;
#pragma unroll
  for (int s0 = 0; s0 < KK / 16; s0 += 4) {
    bf16x8 a[4], b[4][NT];
#pragma unroll
    for (int s = 0; s < 4; ++s) {
      a[s] = *(const bf16x8*)(ap + (s0 + s) * 16);
#pragma unroll
      for (int t = 0; t < NT; ++t) b[s][t] = *(const bf16x8*)(bp + (size_t)(t * 32) * ldb + (s0 + s) * 16);
    }
#pragma unroll
    for (int s = 0; s < 4; ++s)
#pragma unroll
      for (int t = 0; t < NT; ++t) acc[t] = MFMA(a[s], b[s][t], acc[t]);
    __builtin_amdgcn_sched_barrier(0);
  }
}

struct TileInfo { int g0, b, pos0, lo, hi; };
DI TileInfo tile_info(int tile) {
  TileInfo t;
  t.g0 = tile * 32; t.b = t.g0 / NP; t.pos0 = t.g0 - t.b * NP;
  if (t.pos0 < CL) { t.lo = 0; t.hi = CL; } else { t.lo = CL; t.hi = NP; }
  return t;
}

DI void unpack8(const u32x4& v, float* f) {
#pragma unroll
  for (int k = 0; k < 4; ++k) { f[2 * k] = bflo(v[k]); f[2 * k + 1] = bfhi(v[k]); }
}
DI u32x4 pack8(const float* f) {
  u32x4 o;
#pragma unroll
  for (int k = 0; k < 4; ++k) o[k] = pack2(f[2 * k], f[2 * k + 1]);
  return o;
}
DI u32x4 pack8t(const float* f) {
  u32x4 o;
#pragma unroll
  for (int k = 0; k < 4; ++k) o[k] = (unsigned)f2bf(f[2 * k]) | (__float_as_uint(f[2 * k + 1]) & 0xffff0000u);
  return o;
}
DI void load8f(const float* q, float* f) {
  float4 a = *(const float4*)q, b = *(const float4*)(q + 4);
  f[0] = a.x; f[1] = a.y; f[2] = a.z; f[3] = a.w; f[4] = b.x; f[5] = b.y; f[6] = b.z; f[7] = b.w;
}
DI void lds8f(const float* q, float* f) { load8f(q, f); }

template <int NT>
DI void stage_acc(u16* O, int ldo, int col0, const f32x16* acc, int r, int h, float scale) {
#pragma unroll
  for (int t = 0; t < NT; ++t)
#pragma unroll
    for (int i = 0; i < 16; ++i) O[crow(i, h) * ldo + col0 + t * 32 + r] = f2bf(acc[t][i] * scale);
}

DI void prep_conv(const Params& pp, int l, int tile, char* smem) {
  const PW p = {opaque_p(pp.ws), pp.out, pp.wave64};
  const TileInfo ti = tile_info(tile);
  const u16* P = (const u16*)(p.ws + WS_BIG + BIG_P);
  u16* Ycat = (u16*)(p.ws + WS_H);
  u16* U = (u16*)smem;
  u16* Wb = (u16*)(smem + 31744);
  u16* A = (u16*)smem;
  u16* O = (u16*)(smem + 16896);
  const int tid = opaque(TIDX), lane = tid & 63, wave = tid >> 6, r = lane & 31, h = lane >> 5;
  const int cg = tid & 31, tq = tid >> 5, c0 = cg * 8;
  __syncthreads();
  {
    const float* dw = IN(10) + (size_t)l * 31 * 256;
#pragma unroll 8
    for (int j = 0; j < 31; ++j) Wb[j * 256 + tid] = f2bf(dw[j * 256 + tid]);
  }
#pragma unroll 4
  for (int i = 0; i < 8; ++i) {
    int e = tid + 256 * i;
    if (e < 62 * 32) {
      int tt = e >> 5, g8 = e & 31;
      int pos = ti.pos0 - 15 + tt;
      bool valid = (pos >= ti.lo) && (pos < ti.hi);
      int pc = min(max(pos, ti.lo), ti.hi - 1);
      const u16* pr = P + (size_t)(ti.b * NP + pc) * PIN + g8 * 8;
      u32x4 va = *(const u32x4*)pr, vg = *(const u32x4*)(pr + 256);
      float fa[8], fg[8];
      unpack8(va, fa); unpack8(vg, fg);
#pragma unroll
      for (int k = 0; k < 8; ++k) fa[k] = valid ? fa[k] * sigm(fg[k]) : 0.f;
      *(u32x4*)(U + tt * 256 + g8 * 8) = pack8(fa);
    }
  }
  __syncthreads();
  float y[4][8];
#pragma unroll
  for (int t = 0; t < 4; ++t)
#pragma unroll
    for (int e = 0; e < 8; ++e) y[t][e] = 0.f;
  {
    float uw[4][8];
#pragma unroll
    for (int t = 0; t < 3; ++t) unpack8(*(const u32x4*)(U + (4 * tq + t) * 256 + c0), uw[t + 1]);
#pragma unroll 1
    for (int j = 0; j < 31; ++j) {
#pragma unroll
      for (int e = 0; e < 8; ++e) { uw[0][e] = uw[1][e]; uw[1][e] = uw[2][e]; uw[2][e] = uw[3][e]; }
      unpack8(*(const u32x4*)(U + (4 * tq + j + 3) * 256 + c0), uw[3]);
      float w8[8];
      unpack8(*(const u32x4*)(Wb + j * 256 + c0), w8);
#pragma unroll
      for (int t = 0; t < 4; ++t)
#pragma unroll
        for (int e = 0; e < 8; ++e) y[t][e] += uw[t][e] * w8[e];
    }
  }
  {
    float db[8], gg[8], gb[8];
    load8f(IN(11) + l * 256 + c0, db); load8f(IN(12) + l * 256 + c0, gg); load8f(IN(13) + l * 256 + c0, gb);
#pragma unroll
    for (int t = 0; t < 4; ++t) {
      float sm = 0.f;
#pragma unroll
      for (int e = 0; e < 8; ++e) { y[t][e] += db[e]; sm += y[t][e]; }
      const float mean = sum8(sm) * (1.f / 64.f);
      float sq = 0.f;
#pragma unroll
      for (int e = 0; e < 8; ++e) { y[t][e] -= mean; sq += y[t][e] * y[t][e]; }
      const float rs = rsqrtf(sum8(sq) * (1.f / 64.f) + 1e-5f);
#pragma unroll
      for (int e = 0; e < 8; ++e) { float gn = y[t][e] * rs * gg[e] + gb[e]; y[t][e] = gn * sigm(gn); }
    }
  }
  __syncthreads();
#pragma unroll
  for (int t = 0; t < 4; ++t) *(u32x4*)(A + (4 * tq + t) * 264 + c0) = pack8(y[t]);
  __syncthreads();
  f32x16 acc[2];
  small_gemm<256, 2>(A, 264, (const u16*)(p.ws + WS_WT) + WT_PW, 256, wave * 64, acc);
  stage_acc<2>(O, 264, wave * 64, acc, r, h, 1.f);
  __syncthreads();
#pragma unroll
  for (int i = 0; i < 4; ++i) {
    int e = tid + 256 * i, row = e >> 5, cc = e & 31;
    *(u32x4*)(Ycat + (size_t)(ti.g0 + row) * DM + cc * 8) = *(const u32x4*)(O + row * 264 + cc * 8);
  }
}

template <int W>
DI void pool_body(const float* u, float* d, int pos0, int lo, int hi) {
  const int vz = opaque(0);
#pragma unroll
  for (int t = 0; t < 32; ++t) {
    float s = 0.f;
#pragma unroll
    for (int j = 0; j < W; ++j) s += u[t + 8 - W / 2 + j];
    int pos = pos0 + t + vz;
    int a = max(pos - W / 2, lo), b = min(pos + W / 2, hi);
    d[t] = s / (float)(b - a) - u[t + 8];
  }
}

DI void prep_pool(const Params& pp, int l, int tile, char* smem) {
  const PW p = {opaque_p(pp.ws), pp.out, pp.wave64};
  const TileInfo ti = tile_info(tile);
  const u16* P = (const u16*)(p.ws + WS_BIG + BIG_P);
  u16* Ycat = (u16*)(p.ws + WS_H);
  u16* A = (u16*)smem;
  const int tid = opaque(TIDX), c = tid, lane = tid & 63, wave = tid >> 6, r = lane & 31, h = lane >> 5;
  float u[47];
#pragma unroll
  for (int tt = 0; tt < 47; ++tt) {
    int pos = ti.pos0 - 8 + tt;
    bool valid = (pos >= ti.lo) && (pos < ti.hi);
    int pc = min(max(pos, ti.lo), ti.hi - 1);
    float uv = bf2f(P[(size_t)(ti.b * NP + pc) * PIN + OFF_POOL + c]);
    u[tt] = valid ? uv : 0.f;
  }
  float d[32];
  if (wave == 0) pool_body<2>(u, d, ti.pos0, ti.lo, ti.hi);
  else if (wave == 1) pool_body<4>(u, d, ti.pos0, ti.lo, ti.hi);
  else if (wave == 2) pool_body<8>(u, d, ti.pos0, ti.lo, ti.hi);
  else pool_body<16>(u, d, ti.pos0, ti.lo, ti.hi);
  __syncthreads();
#pragma unroll
  for (int t = 0; t < 32; ++t) A[t * 264 + c] = f2bf(d[t]);
  __syncthreads();
  f32x16 acc[2];
  small_gemm<64, 2>(A + wave * 64, 264, (const u16*)(p.ws + WS_WT) + WT_POOL + wave * 4096, 64, 0, acc);
  u16* O = (u16*)(smem + 16896);
#pragma unroll
  for (int t = 0; t < 2; ++t) {
    int n = wave * 64 + t * 32 + r;
    float sc = IN(16)[l * 256 + n];
#pragma unroll
    for (int i = 0; i < 16; ++i) O[crow(i, h) * 264 + n] = f2bf(acc[t][i] * sc);
  }
  __syncthreads();
#pragma unroll
  for (int i = 0; i < 4; ++i) {
    int e = tid + 256 * i, row = e >> 5, cc = e & 31;
    *(u32x4*)(Ycat + (size_t)(ti.g0 + row) * DM + 512 + cc * 8) = *(const u32x4*)(O + row * 264 + cc * 8);
  }
}

DI float rope_freq(int f) { return exp2f(-(float)f * 1.6609640474436813f); }

DI void prep_q(const Params& pp, int l, int tile, char* smem) {
  const PW p = {opaque_p(pp.ws), pp.out, pp.wave64};
  const TileInfo ti = tile_info(tile);
  const u16* P = (const u16*)(p.ws + WS_BIG + BIG_P);
  u16* Q = (u16*)(p.ws + WS_BIG + BIG_Q);
  u16* A = (u16*)smem;
  const int tid = opaque(TIDX), lane = tid & 63, wave = tid >> 6, r = lane & 31, h = lane >> 5;
  {
    const int t = tid >> 3, j = tid & 7;
    const u16* src = P + (size_t)(ti.g0 + t) * PIN + OFF_Q + j * 32;
    u32x4 v[4];
    float ss = 0.f;
#pragma unroll
    for (int i = 0; i < 4; ++i) {
      v[i] = *(const u32x4*)(src + i * 8);
#pragma unroll
      for (int k = 0; k < 4; ++k) { float a = bflo(v[i][k]), b = bfhi(v[i][k]); ss += a * a + b * b; }
    }
    ss = sum8(ss);
    float rs = rsqrtf(ss * (1.f / 256.f) + 1e-6f);
    const float* qg = IN(29) + l * 256 + j * 32;
    __syncthreads();
#pragma unroll
    for (int i = 0; i < 4; ++i) {
      u32x4 o;
#pragma unroll
      for (int k = 0; k < 4; ++k) {
        float a = bflo(v[i][k]) * rs * qg[i * 8 + 2 * k], b = bfhi(v[i][k]) * rs * qg[i * 8 + 2 * k + 1];
        o[k] = pack2(a, b);
      }
      *(u32x4*)(A + t * 264 + j * 32 + i * 8) = o;
    }
  }
  __syncthreads();
  f32x16 acc[3];
  small_gemm<256, 3>(A, 264, (const u16*)(p.ws + WS_WT) + WT_WUQ, 256, wave * 96, acc);
  const float QS = 0.10206207261596577f * 1.4426950408889634f;
  u16* O = (u16*)(smem + 16896);
  stage_acc<2>(O, 392, wave * 96, acc, r, h, QS);
  const bool lat = ti.pos0 >= CL;
  const float fr = rope_freq(r & 7);
#pragma unroll
  for (int i = 0; i < 16; ++i) {
    float val = acc[2][i];
    float par = __shfl_xor(val, 8, 64);
    int tk = crow(i, h);
    float o = val;
    if (lat) {
      int n = ti.pos0 + tk - CL;
      float pa = (float)((r < 16) ? (n >> 6) : (n & 63));
      float ang = pa * fr;
      float sn = __sinf(ang), cs = __cosf(ang);
      o = (r & 8) ? (par * sn + val * cs) : (val * cs - par * sn);
    }
    O[tk * 392 + wave * 96 + 64 + r] = f2bf(o * QS);
  }
  __syncthreads();
#pragma unroll
  for (int i = 0; i < 6; ++i) {
    int e = tid + 256 * i, row = e / 48, cc = e - row * 48;
    *(u32x4*)(Q + (size_t)(ti.g0 + row) * 384 + cc * 8) = *(const u32x4*)(O + row * 392 + cc * 8);
  }
}

DI void prep_kv(const Params& pp, int l, int tile, char* smem) {
  const PW p = {opaque_p(pp.ws), pp.out, pp.wave64};
  const TileInfo ti = tile_info(tile);
  const u16* P = (const u16*)(p.ws + WS_BIG + BIG_P);
  u16* KN = (u16*)(p.ws + WS_BIG + BIG_KN);
  u16* KR = (u16*)(p.ws + WS_BIG + BIG_KR);
  u16* VT = (u16*)(p.ws + WS_BIG + BIG_VT);
  u16* A = (u16*)smem;
  const int tid = opaque(TIDX), lane = tid & 63, wave = tid >> 6, r = lane & 31, h = lane >> 5;
  const bool lat = ti.pos0 >= CL;
  {
    const int t = tid >> 3, j = tid & 7;
    const u16* src = P + (size_t)(ti.g0 + t) * PIN + OFF_KV + j * 16;
    u32x4 v[2];
    float ss = 0.f;
#pragma unroll
    for (int i = 0; i < 2; ++i) {
      v[i] = *(const u32x4*)(src + i * 8);
#pragma unroll
      for (int k = 0; k < 4; ++k) { float a = bflo(v[i][k]), b = bfhi(v[i][k]); ss += a * a + b * b; }
    }
    ss = sum8(ss);
    float rs = rsqrtf(ss * (1.f / 128.f) + 1e-6f);
    const float* kg = IN(31) + l * 128 + j * 16;
    __syncthreads();
#pragma unroll
    for (int i = 0; i < 2; ++i) {
      u32x4 o;
#pragma unroll
      for (int k = 0; k < 4; ++k) {
        float a = bflo(v[i][k]) * rs * kg[i * 8 + 2 * k], b = bfhi(v[i][k]) * rs * kg[i * 8 + 2 * k + 1];
        o[k] = pack2(a, b);
      }
      *(u32x4*)(A + t * 136 + j * 16 + i * 8) = o;
    }
  }
#pragma unroll
  for (int i = 0; i < 4; ++i) {
    int e = tid + 256 * i, t = e >> 5, dd = e & 31;
    const u16* src = P + (size_t)(ti.g0 + t) * PIN + OFF_KV + 128;
    float val = bf2f(src[dd]), par = bf2f(src[dd ^ 8]);
    float o = val;
    if (lat) {
      int n = ti.pos0 + t - CL;
      float pa = (float)((dd < 16) ? (n >> 6) : (n & 63));
      float ang = pa * rope_freq(dd & 7);
      float sn = __sinf(ang), cs = __cosf(ang);
      o = (dd & 8) ? (par * sn + val * cs) : (val * cs - par * sn);
    }
    KR[(size_t)(ti.g0 + t) * 32 + dd] = f2bf(o);
  }
  __syncthreads();
  f32x16 acc[4];
  small_gemm<128, 4>(A, 136, (const u16*)(p.ws + WS_WT) + WT_WUKV, 128, wave * 128, acc);
  u16* O = (u16*)(smem + 16896);
  stage_acc<2>(O, 264, wave * 64, acc, r, h, 1.f);
#pragma unroll
  for (int t = 0; t < 2; ++t) {
    int dv = t * 32 + r;
    u16* dst = VT + ((size_t)((ti.b * 4 + wave) * 64 + dv)) * NP + ti.pos0;
#pragma unroll
    for (int q = 0; q < 4; ++q) {
      u32x2 o;
      o[0] = pack2(acc[2 + t][4 * q], acc[2 + t][4 * q + 1]);
      o[1] = pack2(acc[2 + t][4 * q + 2], acc[2 + t][4 * q + 3]);
      *(u32x2*)(dst + 8 * q + 4 * h) = o;
    }
  }
  __syncthreads();
#pragma unroll
  for (int i = 0; i < 4; ++i) {
    int e = tid + 256 * i, row = e >> 5, cc = e & 31;
    *(u32x4*)(KN + (size_t)(ti.g0 + row) * 256 + cc * 8) = *(const u32x4*)(O + row * 264 + cc * 8);
  }
}

DI void mix4(const u16* Pcol, const TileInfo& ti, int t0, const float* mp, const float* mn, float (*z)[8]) {
  u32x4 raw[6];
#pragma unroll
  for (int i = 0; i < 6; ++i) {
    int pos = ti.pos0 + t0 - 1 + i;
    bool ok = (pos >= ti.lo) && (pos < ti.hi);
    int pc = min(max(pos, ti.lo), ti.hi - 1);
    u32x4 v = *(const u32x4*)(Pcol + (size_t)(ti.b * NP + pc) * PIN);
    if (!ok) { v[0] = 0u; v[1] = 0u; v[2] = 0u; v[3] = 0u; }
    raw[i] = v;
  }
#pragma unroll
  for (int t = 0; t < 4; ++t) {
    float fp[8], fc[8], fn[8];
    unpack8(raw[t], fp); unpack8(raw[t + 1], fc); unpack8(raw[t + 2], fn);
#pragma unroll
    for (int e = 0; e < 8; ++e) z[t][e] = fc[e] + mp[e] * (fp[e] - fc[e]) + mn[e] * (fn[e] - fc[e]);
  }
}

DI void prep_rwkv(const Params& pp, int l, int tile, char* smem) {
  const PW p = {opaque_p(pp.ws), pp.out, pp.wave64};
  const TileInfo ti = tile_info(tile);
  const u16* P = (const u16*)(p.ws + WS_BIG + BIG_P);
  u16* Ycat = (u16*)(p.ws + WS_H);
  u16* SR = (u16*)(p.ws + WS_BIG + BIG_SR);
  u16* SKK = (u16*)(p.ws + WS_BIG + BIG_SKK);
  u16* SV = (u16*)(p.ws + WS_BIG + BIG_SV);
  u16* A3 = (u16*)smem;
  float* R = (float*)(smem + 25088);
  const u16* wt = (const u16*)(p.ws + WS_WT);
  const int tid = opaque(TIDX), lane = tid & 63, wave = tid >> 6, r = lane & 31, h = lane >> 5;
  const int cg = tid & 31, tq = tid >> 5, c0 = cg * 8, t0 = tq * 4;
  const float* mup = IN(17) + l * 1152;
  const float* mun = IN(18) + l * 1152;
  __syncthreads();
#pragma unroll 2
  for (int i = 0; i < 6; ++i) {
    int e = tid + 256 * i, t = e / 48, jg = e - t * 48, j0 = jg * 8;
    int pos = ti.pos0 + t;
    const u16* pr = P + (size_t)(ti.g0 + t) * PIN + OFF_RW + 768 + j0;
    const bool hp = pos > ti.lo, hn = pos + 1 < ti.hi;
    u32x4 vc = *(const u32x4*)pr;
    u32x4 vp = *(const u32x4*)(pr + (hp ? -PIN : 0));
    u32x4 vn = *(const u32x4*)(pr + (hn ? PIN : 0));
    float fc[8], fp[8], fn[8], mp[8], mn[8], z[8];
    unpack8(vc, fc); unpack8(vp, fp); unpack8(vn, fn);
    load8f(mup + 768 + j0, mp); load8f(mun + 768 + j0, mn);
#pragma unroll
    for (int k = 0; k < 8; ++k) {
      float pv = hp ? fp[k] : 0.f, nx = hn ? fn[k] : 0.f;
      float zz = fc[k] + mp[k] * (pv - fc[k]) + mn[k] * (nx - fc[k]);
      float sg = sigm((jg < 16) ? zz : 2.f * zz);
      z[k] = (jg < 16) ? sg : ((jg < 32) ? (2.f * sg - 1.f) : zz);
    }
    *(u32x4*)(A3 + t * 392 + j0) = pack8(z);
  }
  float zk[4][8], rzk[4][8];
  {
    float mp[8], mn[8], z[4][8];
    load8f(mup + c0, mp); load8f(mun + c0, mn);
    mix4(P + OFF_RW + c0, ti, t0, mp, mn, z);
    float rkw[8];
    load8f(IN(26) + l * 256 + c0, rkw);
#pragma unroll
    for (int t = 0; t < 4; ++t) {
      *(u32x4*)(SR + (size_t)(ti.g0 + t0 + t) * 256 + c0) = pack8t(z[t]);
#pragma unroll
      for (int e = 0; e < 8; ++e) rzk[t][e] = z[t][e] * rkw[e];
    }
    load8f(mup + 512 + c0, mp); load8f(mun + 512 + c0, mn);
    mix4(P + OFF_RW + 512 + c0, ti, t0, mp, mn, z);
#pragma unroll
    for (int t = 0; t < 4; ++t) *(u32x4*)(SV + (size_t)(ti.g0 + t0 + t) * 256 + c0) = pack8(z[t]);
    load8f(mup + 256 + c0, mp); load8f(mun + 256 + c0, mn);
    mix4(P + OFF_RW + 256 + c0, ti, t0, mp, mn, zk);
    float kkw[8];
    load8f(IN(24) + l * 256 + c0, kkw);
#pragma unroll
    for (int t = 0; t < 4; ++t) {
      float kk[8], ss = 0.f;
#pragma unroll
      for (int e = 0; e < 8; ++e) { kk[e] = zk[t][e] * kkw[e]; ss += kk[e] * kk[e]; rzk[t][e] *= zk[t][e]; }
      ss = sum8(ss);
      float inv = 1.f / fmaxf(sqrtf(ss), 1e-12f);
#pragma unroll
      for (int e = 0; e < 8; ++e) kk[e] *= inv;
      *(u32x4*)(SKK + (size_t)(ti.g0 + t0 + t) * 256 + c0) = pack8t(kk);
    }
  }
  __syncthreads();
  f32x16 acc[2];
  small_gemm<128, 2>(A3, 392, wt + WT_RG2, 128, wave * 64, acc);
#pragma unroll
  for (int t = 0; t < 2; ++t)
#pragma unroll
    for (int i = 0; i < 16; ++i) R[crow(i, h) * 260 + wave * 64 + t * 32 + r] = acc[t][i];
  __syncthreads();
#pragma unroll
  for (int t = 0; t < 4; ++t) {
    float g8[8];
    lds8f(R + (t0 + t) * 260 + c0, g8);
    *(u32x4*)(Ycat + (size_t)(ti.g0 + t0 + t) * DM + 256 + c0) = pack8(g8);
  }
  __syncthreads();
  float ka[8];
  load8f(IN(25) + l * 256 + c0, ka);
#pragma unroll 1
  for (int d = 0; d < 2; ++d) {
    u16* SDEC = (u16*)(p.ws + WS_BIG + BIG_SDEC) + (size_t)d * NTOK * 256;
    u16* SKD = (u16*)(p.ws + WS_BIG + BIG_SKD) + (size_t)d * NTOK * 256;
    u16* SB = (u16*)(p.ws + WS_BIG + BIG_SB) + (size_t)d * NTOK * 256;
    float* bo = (float*)(p.ws + WS_BONUS) + (size_t)d * NTOK * 4;
    small_gemm<64, 2>(A3 + 128 + d * 64, 392, wt + WT_RW2 + d * 16384, 64, wave * 64, acc);
#pragma unroll
    for (int t = 0; t < 2; ++t)
#pragma unroll
      for (int i = 0; i < 16; ++i) R[crow(i, h) * 260 + wave * 64 + t * 32 + r] = acc[t][i];
    __syncthreads();
    {
      float w0[8];
      load8f(IN(19) + l * 512 + d * 256 + c0, w0);
#pragma unroll
      for (int t = 0; t < 4; ++t) {
        float x8[8];
        lds8f(R + (t0 + t) * 260 + c0, x8);
#pragma unroll
        for (int e = 0; e < 8; ++e) {
          float ee = sigm(w0[e] + x8[e]) * 0.6065306597126334f;
          x8[e] = 1.f - __expf(-ee);
        }
        *(u32x4*)(SDEC + (size_t)(ti.g0 + t0 + t) * 256 + c0) = pack8t(x8);
      }
    }
    __syncthreads();
    small_gemm<64, 2>(A3 + 256 + d * 64, 392, wt + WT_RA2 + d * 16384, 64, wave * 64, acc);
#pragma unroll
    for (int t = 0; t < 2; ++t)
#pragma unroll
      for (int i = 0; i < 16; ++i) R[crow(i, h) * 260 + wave * 64 + t * 32 + r] = acc[t][i];
    __syncthreads();
    {
      float a0[8];
      load8f(IN(21) + l * 512 + d * 256 + c0, a0);
      u32x4 kraw[4];
#pragma unroll
      for (int t = 0; t < 4; ++t) kraw[t] = *(const u32x4*)(SKK + (size_t)(ti.g0 + t0 + t) * 256 + c0);
#pragma unroll
      for (int t = 0; t < 4; ++t) {
        float x8[8], kn[8], kd[8], bb[8], part = 0.f;
        lds8f(R + (t0 + t) * 260 + c0, x8);
        unpack8(kraw[t], kn);
#pragma unroll
        for (int e = 0; e < 8; ++e) {
          float a = sigm(a0[e] + x8[e]);
          float kf = 1.f + (a - 1.f) * ka[e];
          kd[e] = zk[t][e] * kf;
          bb[e] = kn[e] * a;
          part += rzk[t][e] * kf;
        }
        size_t o = (size_t)(ti.g0 + t0 + t) * 256 + c0;
        *(u32x4*)(SKD + o) = pack8t(kd);
        *(u32x4*)(SB + o) = pack8t(bb);
        part = sum8(part);
        if ((cg & 7) == 0) bo[(size_t)(ti.g0 + t0 + t) * 4 + (cg >> 3)] = part;
      }
    }
    __syncthreads();
  }
}

DI void prep_phase(const Params& p, int l, char* smem) {
  const int NT = NTOK / 32;
  for (int item = blockIdx.x; item < 3 * NT; item += gridDim.x) {
    int task = item / NT, tile = item - task * NT;
    bool ctx = (tile % 72) < 8;
    if (l == 1 && ctx && task == 1) continue;
    if (task == 0) prep_rwkv(p, l, tile, smem);
    else if (task == 1) prep_q(p, l, tile, smem);
    else prep_kv(p, l, tile, smem);
  }
}

DI void scan_item(const Params& pp, int item, char* smem) {
  const PW p = {opaque_p(pp.ws), pp.out, pp.wave64};
  const int rh = item & 1, d = (item >> 1) & 1, hd = (item >> 2) & 3, b = item >> 4;
  const int tid = opaque(TIDX), rowl = tid >> 3, ks = tid & 7;
  const u16* arr[5];
  arr[0] = (const u16*)(p.ws + WS_BIG + BIG_SR);
  arr[1] = (const u16*)(p.ws + WS_BIG + BIG_SKK);
  arr[2] = (const u16*)(p.ws + WS_BIG + BIG_SDEC) + (size_t)d * NTOK * 256;
  arr[3] = (const u16*)(p.ws + WS_BIG + BIG_SKD) + (size_t)d * NTOK * 256;
  arr[4] = (const u16*)(p.ws + WS_BIG + BIG_SB) + (size_t)d * NTOK * 256;
  const u16* SV = (const u16*)(p.ws + WS_BIG + BIG_SV);
  constexpr int CH = 32, BUFB = CH * 640 + CH * 64;
  int sj[5], soff[5];
  const u16* sbase[5];
#pragma unroll
  for (int i = 0; i < 5; ++i) {
    int e = tid + 256 * i, j = e / 40, rem = e - j * 40, a = rem >> 3, part = rem & 7;
    sj[i] = j; soff[i] = j * 640 + a * 128 + part * 16;
    sbase[i] = (a == 0 ? arr[0] : a == 1 ? arr[1] : a == 2 ? arr[2] : a == 3 ? arr[3] : arr[4]) + hd * 64 + part * 8;
  }
  const int vj = (tid >> 2) & 31, vpart = tid & 3;
  const u16* vbase = SV + hd * 64 + rh * 32 + vpart * 8;
  const int voff = CH * 640 + vj * 64 + vpart * 16;
  u32x4 rg[6];
  auto pos_of = [&](int s) -> int { return d == 0 ? s : (s < CL ? (CL - 1 - s) : (NP + CL - 1 - s)); };
  auto gload = [&](int cidx) {
#pragma unroll
    for (int i = 0; i < 5; ++i) {
      size_t g = (size_t)b * NP + pos_of(cidx * CH + sj[i]);
      rg[i] = *(const u32x4*)(sbase[i] + g * 256);
    }
    if (tid < 128) {
      size_t g = (size_t)b * NP + pos_of(cidx * CH + vj);
      rg[5] = *(const u32x4*)(vbase + g * 256);
    }
  };
  auto lstore = [&](int bufi) {
    char* bp = smem + bufi * BUFB;
#pragma unroll
    for (int i = 0; i < 5; ++i) *(u32x4*)(bp + soff[i]) = rg[i];
    if (tid < 128) *(u32x4*)(bp + voff) = rg[5];
  };
  f2 S[4];
#pragma unroll
  for (int j = 0; j < 4; ++j) S[j] = (f2){0.f, 0.f};
  constexpr int NCH = NP / CH;
  float* Yb = (float*)(smem + 2 * BUFB);
  const int wj = tid >> 3, wp = tid & 7;
  __syncthreads();
  gload(0);
  lstore(0);
  gload(1);
  __syncthreads();
  for (int cidx = 0; cidx < NCH; ++cidx) {
    if (cidx + 1 < NCH) lstore((cidx + 1) & 1);
    if (cidx + 2 < NCH) gload(cidx + 2);
    if (cidx > 0) {
      u32x4 yv = *(const u32x4*)(Yb + ((cidx - 1) & 1) * CH * 32 + wj * 32 + wp * 4);
      size_t g = (size_t)b * NP + pos_of((cidx - 1) * CH + wj);
      *(u32x4*)(yrow(p.ws, g, d) + hd * 64 + rh * 32 + wp * 4) = yv;
    }
    const char* bp = smem + (cidx & 1) * BUFB;
    float* yb = Yb + (cidx & 1) * CH * 32;
#pragma unroll 8
    for (int j = 0; j < CH; ++j) {
      const char* sp = bp + j * 640 + ks * 16;
      u32x4 r8 = *(const u32x4*)(sp);
      u32x4 k8 = *(const u32x4*)(sp + 128);
      u32x4 d8 = *(const u32x4*)(sp + 256);
      u32x4 kd8 = *(const u32x4*)(sp + 384);
      u32x4 b8 = *(const u32x4*)(sp + 512);
      float vv = bf2f(*(const u16*)(bp + CH * 640 + j * 64 + rowl * 2));
      f2 K2[4], R2[4], D2[4], KD2[4], B2[4];
#define UNPK(dst, src)                                                                   \
      dst[0] = __builtin_bit_cast(f2, __builtin_shufflevector(src, src, 0, 1));           \
      dst[1] = __builtin_bit_cast(f2, __builtin_shufflevector(src, src, 2, 3));           \
      dst[2] = (f2){bflo(src[0]), bflo(src[1])};                                          \
      dst[3] = (f2){bflo(src[2]), bflo(src[3])};
      UNPK(K2, k8) UNPK(R2, r8) UNPK(D2, d8) UNPK(KD2, kd8) UNPK(B2, b8)
#undef UNPK
      f2 sa2 = S[0] * K2[0];
      f2 sb2 = S[1] * K2[1];
      sa2 = S[2] * K2[2] + sa2;
      sb2 = S[3] * K2[3] + sb2;
      sa2 = sa2 + sb2;
      const float sa = sum8(sa2.x + sa2.y);
      const f2 vv2 = (f2){vv, vv}, san = (f2){-sa, -sa};
      f2 y2 = (f2){0.f, 0.f}, y3 = (f2){0.f, 0.f};
#pragma unroll
      for (int q = 0; q < 4; ++q) {
        f2 t = vv2 * KD2[q];
        t = san * B2[q] + t;
        f2 sn = S[q] - S[q] * D2[q];
        sn = sn + t;
        S[q] = sn;
        if (q & 1) y3 = sn * R2[q] + y3; else y2 = sn * R2[q] + y2;
      }
      y2 = y2 + y3;
      const float y = sum8(y2.x + y2.y);
      if (ks == 0) yb[j * 32 + rowl] = y;
    }
    __syncthreads();
  }
  {
    u32x4 yv = *(const u32x4*)(Yb + ((NCH - 1) & 1) * CH * 32 + wj * 32 + wp * 4);
    size_t g = (size_t)b * NP + pos_of((NCH - 1) * CH + wj);
    *(u32x4*)(yrow(p.ws, g, d) + hd * 64 + rh * 32 + wp * 4) = yv;
  }
}

DI void attn_item(const Params& pp, int item, char* smem) {
  const PW p = {opaque_p(pp.ws), pp.out, pp.wave64};
  int b, hd, q0, nkt;
  if (item < 1024) { b = item >> 6; hd = (item >> 4) & 3; q0 = CL + (item & 15) * 128; nkt = NP / 64; }
  else { int x = item - 1024; b = x >> 3; hd = (x >> 1) & 3; q0 = (x & 1) * 128; nkt = CL / 64; }
  const u16* Q = (const u16*)(p.ws + WS_BIG + BIG_Q);
  const u16* KN = (const u16*)(p.ws + WS_BIG + BIG_KN);
  const u16* KR = (const u16*)(p.ws + WS_BIG + BIG_KR);
  const u16* VT = (const u16*)(p.ws + WS_BIG + BIG_VT);
  u16* Ycat = (u16*)(p.ws + WS_H);
  u16* Ks = (u16*)smem;
  u16* Vs = Ks + 64 * 104;
  const int tid = opaque(TIDX), lane = tid & 63, wave = tid >> 6, r = lane & 31, h = lane >> 5;
  const size_t gq = (size_t)b * NP + q0 + wave * 32 + r;
  bf16x8 qf[6];
#pragma unroll
  for (int s = 0; s < 6; ++s) qf[s] = *(const bf16x8*)(Q + gq * 384 + hd * 96 + s * 16 + h * 8);
  f32x16 oacc[2];
#pragma unroll
  for (int t = 0; t < 2; ++t)
#pragma unroll
    for (int i = 0; i < 16; ++i) oacc[t][i] = 0.f;
  float m = -1e30f, lsum = 0.f;
  u32x4 rk[3], rv[2];
  auto gload = [&](int kt) {
    const size_t gk0 = (size_t)b * NP + kt * 64;
#pragma unroll
    for (int i = 0; i < 3; ++i) {
      int e = tid + 256 * i, key = e / 12, part = e - key * 12;
      const u16* src = (part < 8) ? (KN + (gk0 + key) * 256 + hd * 64 + part * 8) : (KR + (gk0 + key) * 32 + (part - 8) * 8);
      rk[i] = *(const u32x4*)src;
    }
#pragma unroll
    for (int i = 0; i < 2; ++i) {
      int e = tid + 256 * i, dv = e >> 3, part = e & 7;
      rv[i] = *(const u32x4*)(VT + ((size_t)((b * 4 + hd) * 64 + dv)) * NP + kt * 64 + part * 8);
    }
  };
  gload(0);
  for (int kt = 0; kt < nkt; ++kt) {
    __syncthreads();
#pragma unroll
    for (int i = 0; i < 3; ++i) {
      int e = tid + 256 * i, key = e / 12, part = e - key * 12;
      *(u32x4*)(Ks + key * 104 + part * 8) = rk[i];
    }
#pragma unroll
    for (int i = 0; i < 2; ++i) {
      int e = tid + 256 * i, dv = e >> 3, part = e & 7;
      *(u32x4*)(Vs + dv * 72 + part * 8) = rv[i];
    }
    __syncthreads();
    if (kt + 1 < nkt) gload(kt + 1);
    f32x16 sacc[2];
#pragma unroll
    for (int t = 0; t < 2; ++t) {
#pragma unroll
      for (int i = 0; i < 16; ++i) sacc[t][i] = 0.f;
#pragma unroll
      for (int s = 0; s < 6; ++s) {
        bf16x8 kf = *(const bf16x8*)(Ks + (t * 32 + r) * 104 + s * 16 + h * 8);
        sacc[t] = MFMA(kf, qf[s], sacc[t]);
      }
    }
    float mloc = sacc[0][0];
#pragma unroll
    for (int i = 1; i < 16; ++i) mloc = fmaxf(mloc, sacc[0][i]);
#pragma unroll
    for (int i = 0; i < 16; ++i) mloc = fmaxf(mloc, sacc[1][i]);
    mloc = fmaxf(mloc, __shfl_xor(mloc, 32, 64));
    float mnew = fmaxf(m, mloc);
    float alpha = __builtin_amdgcn_exp2f(m - mnew);
    m = mnew;
    float ls = 0.f;
#pragma unroll
    for (int t = 0; t < 2; ++t)
#pragma unroll
      for (int i = 0; i < 16; ++i) { float e = __builtin_amdgcn_exp2f(sacc[t][i] - mnew); sacc[t][i] = e; ls += e; }
    lsum = lsum * alpha + ls;
#pragma unroll
    for (int t = 0; t < 2; ++t)
#pragma unroll
      for (int i = 0; i < 16; ++i) oacc[t][i] *= alpha;
#pragma unroll
    for (int s4 = 0; s4 < 4; ++s4) {
      const int t2 = s4 >> 1, ss = s4 & 1;
      u32x4 pk;
#pragma unroll
      for (int q = 0; q < 4; ++q) pk[q] = pack2(sacc[t2][8 * ss + 2 * q], sacc[t2][8 * ss + 2 * q + 1]);
      bf16x8 pf = __builtin_bit_cast(bf16x8, pk);
#pragma unroll
      for (int dt = 0; dt < 2; ++dt) {
        const u16* vp = Vs + (dt * 32 + r) * 72 + t2 * 32 + 16 * ss + 4 * h;
        u32x2 lo = *(const u32x2*)(vp);
        u32x2 hi = *(const u32x2*)(vp + 8);
        u32x4 vv; vv[0] = lo[0]; vv[1] = lo[1]; vv[2] = hi[0]; vv[3] = hi[1];
        oacc[dt] = MFMA(__builtin_bit_cast(bf16x8, vv), pf, oacc[dt]);
      }
    }
  }
  lsum += __shfl_xor(lsum, 32, 64);
  const float inv = 1.f / lsum;
#pragma unroll
  for (int dt = 0; dt < 2; ++dt)
#pragma unroll
    for (int q = 0; q < 4; ++q) {
      u32x2 o;
      o[0] = pack2(oacc[dt][4 * q] * inv, oacc[dt][4 * q + 1] * inv);
      o[1] = pack2(oacc[dt][4 * q + 2] * inv, oacc[dt][4 * q + 3] * inv);
      *(u32x2*)(Ycat + gq * DM + 768 + hd * 64 + dt * 32 + 8 * q + 4 * h) = o;
    }
}

DI void scan_attn_phase(const Params& p, int l, char* smem) {
  for (int rep = 0; rep < opaque_s(PROBE == 2 ? 2 : 1); ++rep)
    for (int item = blockIdx.x; item < 256; item += gridDim.x) scan_item(p, item, smem);
  const int nattn = (l == 0) ? 1024 + 128 : 1024;
  const int NT = NTOK / 32;
  const int nitems = nattn + 2 * NT;
  unsigned* cnt = (unsigned*)(p.ws + WS_CNT) + l;
  int* sh = (int*)(smem + SMEM_BYTES - 16);
  while (true) {
    __syncthreads();
    if (TIDX == 0) *sh = (int)atomicAdd(cnt, 1u);
    __syncthreads();
    int item = *sh;
    if (item >= nitems) break;
    if (item < nattn) { attn_item(p, item, smem); continue; }
    int x = item - nattn;
    int task = x / NT, tile = x - task * NT;
    if (l == 1 && (tile % 72) < 8) continue;
    if (task == 0) prep_conv(p, l, tile, smem);
    else prep_pool(p, l, tile, smem);
  }
}

DI void rwkv_post_phase(const Params& p, int l) {
  const int lane = TIDX & 63, wave = TIDX >> 6;
  const int gwv = blockIdx.x * 4 + wave, nw = gridDim.x * 4;
  const u16* SV = (const u16*)(p.ws + WS_BIG + BIG_SV);
  const float* BONUS = (const float*)(p.ws + WS_BONUS);
  u16* Ycat = (u16*)(p.ws + WS_H);
  const int first = (l == 1) ? CL : 0, per_b = NP - first;
  const int total = NB * per_b * 4;
  for (int base = gwv * 4; base < total; base += nw * 4) {
    float y[4], bn[4], sv[4], gt[4];
    int gi[4], ci[4];
#pragma unroll
    for (int k = 0; k < 4; ++k) {
      int idx = base + k;
      int tk = idx >> 2, hd = idx & 3;
      int b = tk / per_b, pos = first + (tk - b * per_b);
      int g = b * NP + pos, c = hd * 64 + lane;
      gi[k] = g; ci[k] = c;
      y[k] = yrow(p.ws, (size_t)g, 0)[c] + yrow(p.ws, (size_t)g, 1)[c];
      bn[k] = BONUS[(size_t)g * 4 + hd] + BONUS[(size_t)NTOK * 4 + (size_t)g * 4 + hd];
      sv[k] = bf2f(SV[(size_t)g * 256 + c]);
      gt[k] = bf2f(Ycat[(size_t)g * DM + 256 + c]);
    }
#pragma unroll
    for (int k = 0; k < 4; ++k) {
      float mean = wsum(y[k]) * (1.f / 64.f);
      float d = y[k] - mean;
      float var = wsum(d * d) * (1.f / 64.f);
      float o = d * rsqrtf(var + 64e-5f) * IN(27)[l * 256 + ci[k]] + IN(28)[l * 256 + ci[k]];
      o = (o + bn[k] * sv[k]) * gt[k];
      Ycat[(size_t)gi[k] * DM + 256 + ci[k]] = f2bf(o);
    }
  }
}

#define XB_TMO      128
#define XB_XCNT(j)  (256  + 64 * (j))
#define XB_XSUB(j)  (1280 + 64 * (j))
#define XB_XGEN(j)  (2304 + 64 * (j))
#define XB_TOP      3328
#define XB_TOPGEN   3392
#define XCD_BAR_WORDS 3456
#define XB_SPIN_CAP (1u << 18)
#define LAS __attribute__((address_space(3)))
DI unsigned xb_ld(unsigned* p)              { return __hip_atomic_load(p, __ATOMIC_RELAXED, __HIP_MEMORY_SCOPE_AGENT); }
DI unsigned xb_add(unsigned* p, unsigned v) { return __hip_atomic_fetch_add(p, v, __ATOMIC_RELAXED, __HIP_MEMORY_SCOPE_AGENT); }
DI unsigned xb_xcc_id() { return (unsigned)__builtin_amdgcn_s_getreg((3 << 11) | 20) & 0xFu; }
#define XB_SPIN(cond, bar) do { unsigned _sp = 0; while (cond) { __builtin_amdgcn_s_sleep(1); \
    if ((++_sp & 255u) == 0u) { if (xb_ld(&(bar)[XB_TMO])) break; if (_sp > XB_SPIN_CAP) { atomicAdd(&(bar)[XB_TMO], 1u); break; } } } } while (0)
struct XcdBarrier { unsigned* bar; unsigned x; volatile LAS unsigned* st; int tid; };
DI XcdBarrier xcd_barrier_post(unsigned* bar, volatile LAS unsigned* st, int tid) {
  XcdBarrier b; b.bar = bar; b.x = xb_xcc_id(); b.st = st; b.tid = tid;
  if (tid == 0) (void)xb_add(&bar[XB_XCNT(b.x)], 1u);
  return b;
}
DI void xcd_barrier_complete(unsigned* bar, unsigned x, unsigned& nloc, unsigned& nx) {
  const unsigned G = gridDim.x * gridDim.y * gridDim.z;
  unsigned sum, cnt, mine, sp = 0u;
  for (;;) {
    sum = 0u; cnt = 0u; mine = 0u;
#pragma unroll
    for (unsigned j = 0; j < 16; ++j) { const unsigned c = xb_ld(&bar[XB_XCNT(j)]); sum += c; cnt += (c > 0u) ? 1u : 0u; mine = (j == x) ? c : mine; }
    if (sum == G) break;
    __builtin_amdgcn_s_sleep(1);
    if ((++sp & 255u) == 0u) { if (xb_ld(&bar[XB_TMO])) break; if (sp > XB_SPIN_CAP) { atomicAdd(&bar[XB_TMO], 1u); break; } }
  }
  nloc = mine > 0u ? mine : 1u; nx = cnt > 0u ? cnt : 1u;
}
DI void xcd_barrier(const XcdBarrier& b) {
  asm volatile("s_waitcnt vmcnt(0)" ::: "memory");
  __syncthreads();
  if (b.tid == 0) {
    unsigned* bar = b.bar;
    __builtin_amdgcn_s_waitcnt(0);
    unsigned nloc = b.st[0], nx = b.st[1];
    if (nloc == 0u) { xcd_barrier_complete(bar, b.x, nloc, nx); b.st[0] = nloc; b.st[1] = nx; }
    const unsigned old = xb_add(&bar[XB_XSUB(b.x)], 1u);
    const unsigned gen = old / nloc;
    if (old + 1u == (gen + 1u) * nloc) {
      __builtin_amdgcn_fence(__ATOMIC_RELEASE, "agent");
      asm volatile("s_waitcnt vmcnt(0)" ::: "memory");
      const unsigned og = xb_add(&bar[XB_TOP], 1u);
      const unsigned tg = og / nx;
      if (og + 1u == (tg + 1u) * nx) xb_add(&bar[XB_TOPGEN], 1u);
      else XB_SPIN(xb_ld(&bar[XB_TOPGEN]) == tg, bar);
      __builtin_amdgcn_fence(__ATOMIC_ACQUIRE, "agent");
      xb_add(&bar[XB_XGEN(b.x)], 1u);
      asm volatile("s_waitcnt vmcnt(0)" ::: "memory");
    } else {
      XB_SPIN(xb_ld(&bar[XB_XGEN(b.x)]) == gen, bar);
      __builtin_amdgcn_fence(__ATOMIC_ACQUIRE, "agent");
      asm volatile("s_waitcnt vmcnt(0)" ::: "memory");
    }
  }
  __syncthreads();
}

DI void write_table(const Params& p) {
  const float** tab = (const float**)(p.ws + WS_TAB);
#define TB(i) tab[i] = p.in[i];
  TB(0) TB(1) TB(2) TB(3) TB(4) TB(5) TB(6) TB(7) TB(8) TB(9) TB(10) TB(11) TB(12) TB(13) TB(14) TB(15) TB(16) TB(17)
  TB(18) TB(19) TB(20) TB(21) TB(22) TB(23) TB(24) TB(25) TB(26) TB(27) TB(28) TB(29) TB(30) TB(31) TB(32) TB(33) TB(34) TB(35)
#undef TB
}

#define PHASE(k, ...) { if (ph_lo <= (k) && (k) < ph_hi) { if ((k) > ph_lo) { xcd_barrier(xb); } for (int rep_ = 0; rep_ < opaque_s((PROBE - 100 == (k)) ? 2 : 1); ++rep_) { __VA_ARGS__; } } }
template <int L>
DI void layer_phases(const Params& p, cg::grid_group& grid, const XcdBarrier& xb, char* smem, int ph_lo, int ph_hi) {
  const u16* wt = (const u16*)(p.ws + WS_WT);
  const u16* H = (const u16*)(p.ws + WS_H);
  constexpr bool last = (L == 1);
  constexpr int base = 1 + 9 * L;
  PHASE(base + 0, {
    if (L == 1) for (int item = blockIdx.x; item < N_CONV_TILES; item += gridDim.x) convert_item<false>(p, 1, item, smem);
    norm_phase(p, L, IN(6) + L * 1024, 0, 1, L == 0, false);
  })
  PHASE(base + 1, (gemm_phase<4, 0>(p, H, DM, wt + WT_WIN, 1024, PINP / 128, smem, L, 0, false, false)))
  PHASE(base + 2, {
    for (int rep = 0; rep < opaque_s(PROBE == 3 ? 2 : 1); ++rep) prep_phase(p, L, smem);
  })
  PHASE(base + 3, scan_attn_phase(p, L, smem))
  PHASE(base + 4, rwkv_post_phase(p, L))
  PHASE(base + 5, (gemm_phase<2, 1>(p, H, DM, wt + WT_WOUT, 1024, 8, smem, L, 2, L == 0, last)))
  PHASE(base + 6, norm_phase(p, L, IN(7) + L * 1024, 3, 4, false, last))
  PHASE(base + 7, {
    for (int rep = 0; rep < opaque_s(PROBE == 1 ? 2 : 1); ++rep) gemm_phase<4, 2>(p, H, DM, wt + WT_W1, 1024, 32, smem, L, 0, false, last);
  })
  PHASE(base + 8, (gemm_phase<2, 1>(p, (const u16*)(p.ws + WS_BIG), DFF, wt + WT_W2, 4096, 8, smem, L, 5, false, last)))
}

__global__ void __launch_bounds__(256, 2) mega(Params p_, int ph_lo, int ph_hi) {
  __shared__ __attribute__((aligned(16))) char smem[SMEM_BYTES];
  __shared__ uint4 xb_words;
  cg::grid_group grid = cg::this_grid();
  if (ph_hi > 1000) grid.sync();
  Params p = p_;
  p.wave64 = __builtin_amdgcn_readfirstlane((int)threadIdx.x) & ~63;
  const int tid_ = TIDX;
  if (tid_ == 0) xb_words = make_uint4(0u, 0u, 0u, 0u);
  __syncthreads();
  const XcdBarrier xb = xcd_barrier_post((unsigned*)(p.ws + WS_BAR), (volatile LAS unsigned*)&xb_words, tid_);
  PHASE(0, {
    if (blockIdx.x == 0 && tid_ == 0) {
      unsigned* cn = (unsigned*)(p.ws + WS_CNT);
      cn[0] = 0u; cn[1] = 0u; cn[2] = 0u; cn[3] = 0u;
      write_table(p);
    }
    for (int item = blockIdx.x; item < 192 + N_CONV_TILES; item += gridDim.x) {
      if (item < 192) mod_item(p, item, smem);
      else convert_item<true>(p, 0, item - 192, smem);
    }
  })
  layer_phases<0>(p, grid, xb, smem, ph_lo, ph_hi);
  layer_phases<1>(p, grid, xb, smem, ph_lo, ph_hi);
  PHASE(19, final_norm_phase(p))
}

extern "C" void kernel_launch(void* const* d_in, const int* in_sizes, int n_in, void* d_out, int out_size, void* d_ws,
                              size_t ws_size, hipStream_t stream) {
  if (ws_size < WS_TOTAL) { fprintf(stderr, "workspace too small: %zu < %zu\n", ws_size, (size_t)WS_TOTAL); return; }
  static int grid_blocks = 0;
  if (!grid_blocks) {
    int dev = 0, cus = 0, per_cu = 0;
    hipGetDevice(&dev);
    hipDeviceGetAttribute(&cus, hipDeviceAttributeMultiprocessorCount, dev);
    hipOccupancyMaxActiveBlocksPerMultiprocessor(&per_cu, mega, 256, 0);
    if (per_cu > 2) per_cu = 2;
    if (per_cu < 1) per_cu = 1;
    grid_blocks = cus * per_cu;
  }
  Params p{};
  for (int i = 0; i < 36; ++i) p.in[i] = (const float*)d_in[i];
  p.out = (float*)d_out;
  p.ws = (char*)d_ws;
  p.wave64 = 0;
  p.pad_ = 0;
  hipMemsetAsync((char*)d_ws + WS_BAR, 0, XCD_BAR_WORDS * 4, stream);
  int lo = 0, hi = 20;
  void* args[] = {&p, &lo, &hi};
  hipError_t e = hipLaunchCooperativeKernel((void*)mega, dim3(grid_blocks), dim3(256), args, 0, stream);
  if (e != hipSuccess) fprintf(stderr, "cooperative launch failed: %s (grid %d)\n", hipGetErrorString(e), grid_blocks);
}
```

```cpp
#include <hip/hip_runtime.h>
#include <hip/hip_cooperative_groups.h>
#include <cstdio>
namespace cg = cooperative_groups;

#define DI __device__ __forceinline__
typedef unsigned short u16;
typedef __attribute__((ext_vector_type(8))) short bf16x8;
typedef __attribute__((ext_vector_type(16))) float f32x16;
typedef __attribute__((ext_vector_type(4))) unsigned u32x4;
typedef __attribute__((ext_vector_type(2))) unsigned u32x2;
typedef float f2 __attribute__((ext_vector_type(2)));
#define MFMA(a, b, c) __builtin_amdgcn_mfma_f32_32x32x16_bf16((a), (b), (c), 0, 0, 0)

constexpr int NB = 16, TL = 2048, CL = 256, NP = 2304, NTOK = NB * NP, DM = 1024;
constexpr int PIN = 2336, PINP = 2432, DFF = 4096;
constexpr int OFF_POOL = 512, OFF_Q = 768, OFF_RW = 1024, OFF_KV = 2176;

constexpr size_t WT_WIN = 0;
constexpr size_t WT_WOUT = WT_WIN + (size_t)PINP * 1024;
constexpr size_t WT_W1 = WT_WOUT + 1024 * 1024;
constexpr size_t WT_W2 = WT_W1 + 4096 * 1024;
constexpr size_t WT_PW = WT_W2 + 4096 * 1024;
constexpr size_t WT_WUQ = WT_PW + 256 * 256;
constexpr size_t WT_WUKV = WT_WUQ + 384 * 256;
constexpr size_t WT_POOL = WT_WUKV + 512 * 128;
constexpr size_t WT_RW2 = WT_POOL + 4 * 64 * 64;
constexpr size_t WT_RA2 = WT_RW2 + 2 * 256 * 64;
constexpr size_t WT_RG2 = WT_RA2 + 2 * 256 * 64;
constexpr size_t WT_END = WT_RG2 + 256 * 128;
constexpr size_t WS_WT = 0;
constexpr size_t WS_MOD = WS_WT + WT_END * 2;
constexpr size_t WS_XCTX = WS_MOD + (size_t)2 * 17 * 6144 * 4;
constexpr size_t WS_BONUS = WS_XCTX + (size_t)NB * CL * DM * 4;
constexpr size_t WS_CNT = WS_BONUS + (size_t)2 * NTOK * 4 * 4;
constexpr size_t WS_TAB = WS_CNT + 256;
constexpr size_t WS_BAR = WS_TAB + 512;
constexpr size_t WS_H = WS_BAR + 3456 * 4;
constexpr size_t WS_BIG = WS_H + (size_t)NTOK * DM * 2;
constexpr size_t SZ_TOK256 = (size_t)NTOK * 256 * 2;
constexpr size_t BIG_P = 0;
constexpr size_t BIG_Q = BIG_P + (size_t)NTOK * PIN * 2;
constexpr size_t BIG_KN = BIG_Q + (size_t)NTOK * 384 * 2;
constexpr size_t BIG_KR = BIG_KN + SZ_TOK256;
constexpr size_t BIG_VT = BIG_KR + (size_t)NTOK * 32 * 2;
constexpr size_t BIG_SR = BIG_VT + SZ_TOK256;
constexpr size_t BIG_SKK = BIG_SR + SZ_TOK256;
constexpr size_t BIG_SV = BIG_SKK + SZ_TOK256;
constexpr size_t BIG_SDEC = BIG_SV + SZ_TOK256;
constexpr size_t BIG_SKD = BIG_SDEC + 2 * SZ_TOK256;
constexpr size_t BIG_SB = BIG_SKD + 2 * SZ_TOK256;
constexpr size_t BIG_END = BIG_SB + 2 * SZ_TOK256;
DI float* yrow(char* ws, size_t g, int d) { return (float*)(ws + WS_BIG + BIG_P + g * (size_t)(PIN * 2) + OFF_RW * 2 + d * 1024); }
constexpr size_t WS_TOTAL = WS_BIG + BIG_END;
static_assert((size_t)NTOK * DFF * 2 <= BIG_END, "Hff must fit");

constexpr int SMEM_BYTES = 59392;
#ifndef PROBE
#define PROBE 0
#endif

struct Params {
  const float* in[36];
  float* out;
  char* ws;
  int wave64;
  int pad_;
};

DI u16 f2bf(float x) {
  unsigned u = __float_as_uint(x);
  u += 0x7fffu + ((u >> 16) & 1u);
  return (u16)(u >> 16);
}
DI int lane_id_() { unsigned z = 0u; asm volatile("" : "+v"(z)); return (int)__builtin_amdgcn_mbcnt_hi(~0u, __builtin_amdgcn_mbcnt_lo(~0u, z)); }
#define TIDX (p.wave64 + lane_id_())
DI int opaque(int x) { asm volatile("" : "+v"(x)); return x; }
struct PW { char* ws; float* out; int wave64; };
DI char* opaque_p(char* x) { asm volatile("" : "+s"(x)); return x; }
DI int opaque_s(int x) { asm volatile("" : "+s"(x)); return x; }
DI float bf2f(u16 v) { return __uint_as_float(((unsigned)v) << 16); }
DI unsigned pack2(float a, float b) { return (unsigned)f2bf(a) | ((unsigned)f2bf(b) << 16); }
DI float bflo(unsigned u) { return __uint_as_float(u << 16); }
DI float bfhi(unsigned u) { return __uint_as_float(u & 0xffff0000u); }
DI float sigm(float x) { return 1.f / (1.f + __expf(-x)); }
DI int crow(int i, int h) { return (i & 3) + 8 * (i >> 2) + 4 * h; }
DI float dpp_f(float v, int ctrl_sel) {
  int x = __float_as_int(v);
  int r;
  if (ctrl_sel == 0) r = __builtin_amdgcn_update_dpp(0, x, 0xB1, 0xf, 0xf, true);
  else if (ctrl_sel == 1) r = __builtin_amdgcn_update_dpp(0, x, 0x4E, 0xf, 0xf, true);
  else r = __builtin_amdgcn_update_dpp(0, x, 0x141, 0xf, 0xf, true);
  return __int_as_float(r);
}
DI float sum8(float v) {
  v += dpp_f(v, 0);
  v += dpp_f(v, 1);
  v += dpp_f(v, 2);
  return v;
}

DI float wsum(float v) {
  v += dpp_f(v, 0);
  v += dpp_f(v, 1);
  v += dpp_f(v, 2);
  v += __int_as_float(__builtin_amdgcn_update_dpp(0, __float_as_int(v), 0x140, 0xf, 0xf, true));
  int x = __float_as_int(v);
  return (__int_as_float(__builtin_amdgcn_readlane(x, 0)) + __int_as_float(__builtin_amdgcn_readlane(x, 16))) +
         (__int_as_float(__builtin_amdgcn_readlane(x, 32)) + __int_as_float(__builtin_amdgcn_readlane(x, 48)));
}

DI const float* inp(const char* ws, int i) {
  unsigned long long v = ((const unsigned long long*)(ws + WS_TAB))[i];
  unsigned lo = __builtin_amdgcn_readfirstlane((unsigned)v), hi = __builtin_amdgcn_readfirstlane((unsigned)(v >> 32));
  return (const float*)(((unsigned long long)hi << 32) | (unsigned long long)lo);
}
#define IN(i) inp(p.ws, (i))
template <class PT>
DI const float* xsrc_row(const PT& p, bool from_input, int g) {
  int b = g / NP, pos = g - b * NP;
  if (pos < CL) return (from_input ? IN(2) : (const float*)(p.ws + WS_XCTX)) + ((size_t)(b * CL + pos)) * DM;
  return (from_input ? IN(0) : (const float*)p.out) + ((size_t)(b * TL + pos - CL)) * DM;
}
template <class PT>
DI float* xdst_row(const PT& p, int g) {
  int b = g / NP, pos = g - b * NP;
  if (pos < CL) return (float*)(p.ws + WS_XCTX) + ((size_t)(b * CL + pos)) * DM;
  return p.out + ((size_t)(b * TL + pos - CL)) * DM;
}

template <bool DIRECT>
DI void wdesc(const Params& p, int l, int i, const float*& src, u16*& dst, int& K, int& N, int& Npad) {
#define WIN(k) (DIRECT ? p.in[k] : IN(k))
  u16* wt = (u16*)(p.ws + WS_WT);
  if (i == 0) { src = WIN(8) + (size_t)l * 1024 * PIN; dst = wt + WT_WIN; K = 1024; N = PIN; Npad = PINP; }
  else if (i == 1) { src = WIN(9) + (size_t)l * 1024 * 1024; dst = wt + WT_WOUT; K = 1024; N = 1024; Npad = 1024; }
  else if (i == 2) { src = WIN(33) + (size_t)l * 1024 * 4096; dst = wt + WT_W1; K = 1024; N = 4096; Npad = 4096; }
  else if (i == 3) { src = WIN(34) + (size_t)l * 4096 * 1024; dst = wt + WT_W2; K = 4096; N = 1024; Npad = 1024; }
  else if (i == 4) { src = WIN(14) + (size_t)l * 65536; dst = wt + WT_PW; K = 256; N = 256; Npad = 256; }
  else if (i == 5) { src = WIN(30) + (size_t)l * 256 * 384; dst = wt + WT_WUQ; K = 256; N = 384; Npad = 384; }
  else if (i == 6) { src = WIN(32) + (size_t)l * 128 * 512; dst = wt + WT_WUKV; K = 128; N = 512; Npad = 512; }
  else if (i < 11) { src = WIN(15) + (size_t)l * 16384 + (i - 7) * 4096; dst = wt + WT_POOL + (i - 7) * 4096; K = 64; N = 64; Npad = 64; }
  else if (i < 13) { src = WIN(20) + (size_t)l * 32768 + (i - 11) * 16384; dst = wt + WT_RW2 + (i - 11) * 16384; K = 64; N = 256; Npad = 256; }
  else if (i < 15) { src = WIN(22) + (size_t)l * 32768 + (i - 13) * 16384; dst = wt + WT_RA2 + (i - 13) * 16384; K = 64; N = 256; Npad = 256; }
  else { src = WIN(23) + (size_t)l * 32768; dst = wt + WT_RG2; K = 128; N = 256; Npad = 256; }
}
#undef WIN

DI void convert_tile(const float* __restrict__ src, u16* __restrict__ dst, int K, int N, int k0, int n0, char* smem, int tid_in) {
  float* tile = (float*)smem;
  const int tid = opaque(tid_in);
  __syncthreads();
#pragma unroll
  for (int i = 0; i < 16; ++i) {
    int e = tid + 256 * i, kk = e >> 6, nn = e & 63;
    float v = 0.f;
    if (n0 + nn < N) v = src[(size_t)(k0 + kk) * N + n0 + nn];
    tile[kk * 65 + nn] = v;
  }
  __syncthreads();
#pragma unroll
  for (int i = 0; i < 8; ++i) {
    int e = tid + 256 * i, nn = e >> 5, kp = e & 31;
    unsigned v = pack2(tile[(2 * kp) * 65 + nn], tile[(2 * kp + 1) * 65 + nn]);
    *(unsigned*)(dst + (size_t)(n0 + nn) * K + k0 + 2 * kp) = v;
  }
}

constexpr int N_CONV_TILES = 2996;
template <bool DIRECT>
DI void convert_item(const Params& p, int l, int item, char* smem) {
  int acc = 0;
  for (int i = 0; i < 16; ++i) {
    const float* src; u16* dst; int K, N, Npad;
    wdesc<DIRECT>(p, l, i, src, dst, K, N, Npad);
    int tn = Npad >> 6, cnt = (K >> 6) * tn;
    if (item < acc + cnt) {
      int t = item - acc;
      convert_tile(src, dst, K, N, (t / tn) * 64, (t % tn) * 64, smem, TIDX);
      return;
    }
    acc += cnt;
  }
}

DI void mod_item(const Params& p, int item, char* smem) {
  const int l = item / 96, cb = item % 96;
  const int tid = opaque(TIDX), cq = tid & 15, kg = tid >> 4, lane = tid & 63, wave = tid >> 6;
  float* sl = (float*)smem;
  float* red = (float*)(smem + 34816);
  const float* W = p.in[4] + (size_t)l * 1024 * 6144;
  const int col = cb * 64 + cq * 4;
  float acc[17][4];
#pragma unroll
  for (int b = 0; b < 17; ++b) { acc[b][0] = acc[b][1] = acc[b][2] = acc[b][3] = 0.f; }
  for (int half = 0; half < 2; ++half) {
    __syncthreads();
    for (int e = tid; e < 17 * 512; e += 256) {
      int b = e >> 9, k = e & 511;
      float cv = (b < 16) ? p.in[1][b * 1024 + half * 512 + k] : p.in[3][half * 512 + k];
      sl[e] = cv * sigm(cv);
    }
    __syncthreads();
#pragma unroll 8
    for (int kk = 0; kk < 32; ++kk) {
      int kl = kg * 32 + kk;
      float4 w = *(const float4*)(W + (size_t)(half * 512 + kl) * 6144 + col);
#pragma unroll
      for (int b = 0; b < 17; ++b) {
        float s = sl[b * 512 + kl];
        acc[b][0] += s * w.x; acc[b][1] += s * w.y; acc[b][2] += s * w.z; acc[b][3] += s * w.w;
      }
    }
  }
#pragma unroll
  for (int b = 0; b < 17; ++b)
#pragma unroll
    for (int j = 0; j < 4; ++j) {
      float v = acc[b][j];
      v += __shfl_xor(v, 16, 64);
      v += __shfl_xor(v, 32, 64);
      acc[b][j] = v;
    }
  __syncthreads();
  if (lane < 16) {
#pragma unroll
    for (int b = 0; b < 17; ++b)
#pragma unroll
      for (int j = 0; j < 4; ++j) red[(wave * 17 + b) * 64 + cq * 4 + j] = acc[b][j];
  }
  __syncthreads();
  float* mod = (float*)(p.ws + WS_MOD) + (size_t)l * 17 * 6144;
  for (int e = tid; e < 17 * 64; e += 256) {
    int b = e >> 6, cc = e & 63;
    float v = red[(0 * 17 + b) * 64 + cc] + red[(1 * 17 + b) * 64 + cc] + red[(2 * 17 + b) * 64 + cc] + red[(3 * 17 + b) * 64 + cc];
    mod[b * 6144 + cb * 64 + cc] = v + p.in[5][l * 6144 + cb * 64 + cc];
  }
}

DI void norm_phase(const Params& p, int l, const float* gw, int isft, int isc, bool from_input, bool skip_ctx) {
  const int lane = TIDX & 63, wave = TIDX >> 6;
  const int gwv = blockIdx.x * 4 + wave, nw = gridDim.x * 4;
  u16* H = (u16*)(p.ws + WS_H);
  const float* mod = (const float*)(p.ws + WS_MOD) + (size_t)l * 17 * 6144;
  const int first = skip_ctx ? CL : 0, per_b = NP - first, total = NB * per_b;
  constexpr int RB = 4;
  for (int base = gwv; base < total; base += nw * RB) {
    float4 v[RB][4];
    int gi[RB];
#pragma unroll
    for (int k = 0; k < RB; ++k) {
      int idx = min(base + k * nw, total - 1);
      int b = idx / per_b, pos = first + (idx - b * per_b);
      gi[k] = b * NP + pos;
      const float* x = xsrc_row(p, from_input, gi[k]);
      if (from_input) {
#pragma unroll
        for (int i = 0; i < 4; ++i) v[k][i] = *(const float4*)(x + lane * 4 + 256 * i);
      } else {
        const u16* xb = (const u16*)x;
#pragma unroll
        for (int i = 0; i < 4; ++i) {
          u32x2 w = *(const u32x2*)(xb + lane * 4 + 256 * i);
          v[k][i] = make_float4(bflo(w[0]), bfhi(w[0]), bflo(w[1]), bfhi(w[1]));
        }
      }
    }
#pragma unroll
    for (int k = 0; k < RB; ++k) {
      if (base + k * nw >= total) break;
      const int g = gi[k];
      const int b = g / NP, pos = g - b * NP;
      const float* mrow = mod + (size_t)(pos < CL ? 16 : b) * 6144;
      float ss = 0.f;
#pragma unroll
      for (int i = 0; i < 4; ++i) ss += v[k][i].x * v[k][i].x + v[k][i].y * v[k][i].y + v[k][i].z * v[k][i].z + v[k][i].w * v[k][i].w;
      ss = wsum(ss);
      float rs = rsqrtf(ss * (1.f / 1024.f) + 1e-6f);
#pragma unroll
      for (int i = 0; i < 4; ++i) {
        int c = lane * 4 + 256 * i;
        float4 gg = *(const float4*)(gw + c);
        float4 sc = *(const float4*)(mrow + isc * 1024 + c);
        float4 sf = *(const float4*)(mrow + isft * 1024 + c);
        float a0 = v[k][i].x * rs * gg.x * (1.f + sc.x) + sf.x;
        float a1 = v[k][i].y * rs * gg.y * (1.f + sc.y) + sf.y;
        float a2 = v[k][i].z * rs * gg.z * (1.f + sc.z) + sf.z;
        float a3 = v[k][i].w * rs * gg.w * (1.f + sc.w) + sf.w;
        u32x2 o; o[0] = pack2(a0, a1); o[1] = pack2(a2, a3);
        *(u32x2*)(H + (size_t)g * DM + c) = o;
      }
    }
  }
}

DI void final_norm_phase(const Params& p) {
  const int lane = TIDX & 63, wave = TIDX >> 6;
  const int gwv = blockIdx.x * 4 + wave, nw = gridDim.x * 4;
  const float* gw = IN(35);
  constexpr int RB = 4;
  const int total = NB * TL;
  for (int base = gwv; base < total; base += nw * RB) {
    float4 v[RB][4];
#pragma unroll
    for (int k = 0; k < RB; ++k) {
      int row = min(base + k * nw, total - 1);
      const u16* xb = (const u16*)(p.out + (size_t)row * DM);
#pragma unroll
      for (int i = 0; i < 4; ++i) {
        u32x2 w = *(const u32x2*)(xb + lane * 4 + 256 * i);
        v[k][i] = make_float4(bflo(w[0]), bfhi(w[0]), bflo(w[1]), bfhi(w[1]));
      }
    }
#pragma unroll
    for (int k = 0; k < RB; ++k) {
      int row = base + k * nw;
      if (row >= total) break;
      float* x = p.out + (size_t)row * DM;
      float ss = 0.f;
#pragma unroll
      for (int i = 0; i < 4; ++i) ss += v[k][i].x * v[k][i].x + v[k][i].y * v[k][i].y + v[k][i].z * v[k][i].z + v[k][i].w * v[k][i].w;
      ss = wsum(ss);
      float rs = rsqrtf(ss * (1.f / 1024.f) + 1e-6f);
#pragma unroll
      for (int i = 0; i < 4; ++i) {
        int c = lane * 4 + 256 * i;
        float4 gg = *(const float4*)(gw + c);
        float4 o;
        o.x = v[k][i].x * rs * gg.x; o.y = v[k][i].y * rs * gg.y; o.z = v[k][i].z * rs * gg.z; o.w = v[k][i].w * rs * gg.w;
        *(float4*)(x + c) = o;
      }
    }
  }
}

template <int MT, int EPI>
DI void gemm_tile(const Params& pp, const u16* __restrict__ A, int lda, const u16* __restrict__ Bt, int K,
                          int m0, int n0, char* smem, int l, int modidx, bool from_input) {
  const PW p = {opaque_p(pp.ws), pp.out, pp.wave64};
  constexpr int BM = 64 * MT;
  constexpr int LS = 72;
  constexpr int NR = (MT == 2) ? 2 : 1;
  u16* As = (u16*)smem;
  u16* Bs = As + BM * LS;
  const int tid = opaque(TIDX), lane = tid & 63, wave = tid >> 6;
  const int wm = wave >> 1, wn = wave & 1, r = lane & 31, h = lane >> 5;
  f32x16 acc[MT][2];
#pragma unroll
  for (int a = 0; a < MT; ++a)
#pragma unroll
    for (int b = 0; b < 2; ++b)
#pragma unroll
      for (int i = 0; i < 16; ++i) acc[a][b][i] = 0.f;
  u32x4 ra[NR][2 * MT], rb[NR][4];
  const int nk = K >> 6;
  const int lrow = tid >> 3, lkc = tid & 7;
  const char* Abase = (const char*)(A + (size_t)m0 * lda);
  const char* Bbase = (const char*)(Bt + (size_t)n0 * K);
  const unsigned voffA = (unsigned)(lrow * lda + lkc * 8) * 2u;
  const unsigned voffB = (unsigned)(lrow * K + lkc * 8) * 2u;
  const unsigned lds_w = (unsigned)(lrow * LS + lkc * 8);
#define GL(set, kt_)                                                                                      \
  {                                                                                                       \
    _Pragma("unroll") for (int i = 0; i < 2 * MT; ++i)                                                    \
        ra[set][i] = *(const u32x4*)(Abase + ((size_t)(32 * i) * lda + (size_t)(kt_) * 64) * 2 + voffA);  \
    _Pragma("unroll") for (int i = 0; i < 4; ++i)                                                         \
        rb[set][i] = *(const u32x4*)(Bbase + ((size_t)(32 * i) * K + (size_t)(kt_) * 64) * 2 + voffB);    \
  }
  if (MT == 2) {
    GL(0, 0)
    if (nk > 1) GL(1, 1)
    __syncthreads();
#pragma unroll
    for (int i = 0; i < 2 * MT; ++i) *(u32x4*)(As + lds_w + 32 * i * LS) = ra[0][i];
#pragma unroll
    for (int i = 0; i < 4; ++i) *(u32x4*)(Bs + lds_w + 32 * i * LS) = rb[0][i];
    if (nk > 2) GL(0, 2)
    __syncthreads();
    for (int kt = 0; kt < nk; kt += 2) {
#pragma unroll
      for (int s = 0; s < 2; ++s) {
        bf16x8 af[4][MT], bfr[4][2];
#pragma unroll
        for (int ks = 0; ks < 4; ++ks) {
#pragma unroll
          for (int a = 0; a < MT; ++a) af[ks][a] = *(const bf16x8*)(As + (wm * 32 * MT + a * 32 + r) * LS + ks * 16 + h * 8);
#pragma unroll
          for (int b = 0; b < 2; ++b) bfr[ks][b] = *(const bf16x8*)(Bs + (wn * 64 + b * 32 + r) * LS + ks * 16 + h * 8);
        }
        __syncthreads();
        if (kt + s + 1 < nk) {
#pragma unroll
          for (int i = 0; i < 2 * MT; ++i) *(u32x4*)(As + lds_w + 32 * i * LS) = ra[(s + 1) & 1][i];
#pragma unroll
          for (int i = 0; i < 4; ++i) *(u32x4*)(Bs + lds_w + 32 * i * LS) = rb[(s + 1) & 1][i];
          if (kt + s + 3 < nk) GL((s + 1) & 1, kt + s + 3)
        }
#pragma unroll
        for (int ks = 0; ks < 4; ++ks)
#pragma unroll
          for (int a = 0; a < MT; ++a)
#pragma unroll
            for (int b = 0; b < 2; ++b) acc[a][b] = MFMA(af[ks][a], bfr[ks][b], acc[a][b]);
        __syncthreads();
      }
    }
  } else {
#pragma unroll
  for (int s = 0; s < NR; ++s) GL(s, s)
  for (int kt = 0; kt < nk; kt += NR) {

#pragma unroll
    for (int s = 0; s < NR; ++s) {
      __syncthreads();
#pragma unroll
      for (int i = 0; i < 2 * MT; ++i) *(u32x4*)(As + lds_w + 32 * i * LS) = ra[s][i];
#pragma unroll
      for (int i = 0; i < 4; ++i) *(u32x4*)(Bs + lds_w + 32 * i * LS) = rb[s][i];
      __syncthreads();
      if (kt + s + NR < nk) GL(s, kt + s + NR)
#pragma unroll
      for (int ks = 0; ks < 4; ++ks) {
        bf16x8 af[MT], bfr[2];
#pragma unroll
        for (int a = 0; a < MT; ++a) af[a] = *(const bf16x8*)(As + (wm * 32 * MT + a * 32 + r) * LS + ks * 16 + h * 8);
#pragma unroll
        for (int b = 0; b < 2; ++b) bfr[b] = *(const bf16x8*)(Bs + (wn * 64 + b * 32 + r) * LS + ks * 16 + h * 8);
#pragma unroll
        for (int a = 0; a < MT; ++a)
#pragma unroll
          for (int b = 0; b < 2; ++b) acc[a][b] = MFMA(af[a], bfr[b], acc[a][b]);
      }
    }
  }
  }
#undef GL
  if (EPI == 0 || EPI == 2) {
    constexpr int CS = 136;
    constexpr int NPASS = MT / 2;
    u16* Cs = (u16*)smem;
    u16* Cg = (EPI == 0) ? (u16*)(p.ws + WS_BIG + BIG_P) : (u16*)(p.ws + WS_BIG);
    const int ldc = (EPI == 0) ? PIN : DFF;
#pragma unroll
    for (int pass = 0; pass < NPASS; ++pass) {
      __syncthreads();
      if (NPASS == 1 || wm == pass) {
#pragma unroll
        for (int a = 0; a < MT; ++a)
#pragma unroll
          for (int b = 0; b < 2; ++b) {
            u16* cp = Cs + ((NPASS == 1 ? wm * 64 : 0) + a * 32 + 4 * h) * CS + wn * 64 + b * 32 + r;
#pragma unroll
            for (int i = 0; i < 16; ++i) {
              float v = acc[a][b][i];
              if (EPI == 2) { v = fmaxf(v, 0.f); v = v * v; }
              cp[(8 * (i >> 2) + (i & 3)) * CS] = f2bf(v);
            }
          }
      }
      __syncthreads();
#pragma unroll
      for (int i = 0; i < 8; ++i) {
        int e = tid + 256 * i, row = e >> 4, cc = e & 15;
        if (EPI == 2 || n0 + cc * 8 < PIN) {
          u32x4 v = *(const u32x4*)(Cs + row * CS + cc * 8);
          *(u32x4*)(Cg + (size_t)(m0 + pass * 128 + row) * ldc + n0 + cc * 8) = v;
        }
      }
    }
  } else if (EPI == 1) {
    const int bb = m0 / NP, pos0 = m0 - bb * NP;
    const float* src = xsrc_row(p, from_input, m0);
    float* dst = xdst_row(p, m0);
    const float* mrow = (const float*)(p.ws + WS_MOD) + (size_t)l * 17 * 6144 + (size_t)(pos0 < CL ? 16 : bb) * 6144 + modidx * 1024;
#pragma unroll
    for (int b = 0; b < 2; ++b) {
      int col = n0 + wn * 64 + b * 32 + r;
      float mv = mrow[col];
      float xv[MT][16];
#pragma unroll
      for (int a = 0; a < MT; ++a) {
        const float* sp = src + (size_t)(wm * 32 * MT + a * 32 + 4 * h) * DM;
        if (from_input) {
#pragma unroll
          for (int i = 0; i < 16; ++i) xv[a][i] = sp[(size_t)(8 * (i >> 2) + (i & 3)) * DM + col];
        } else {
#pragma unroll
          for (int i = 0; i < 16; ++i) xv[a][i] = bf2f(((const u16*)(sp + (size_t)(8 * (i >> 2) + (i & 3)) * DM))[col]);
        }
      }
#pragma unroll
      for (int a = 0; a < MT; ++a) {
        float* dp = dst + (size_t)(wm * 32 * MT + a * 32 + 4 * h) * DM;
#pragma unroll
        for (int i = 0; i < 16; ++i) ((u16*)(dp + (size_t)(8 * (i >> 2) + (i & 3)) * DM))[col] = f2bf(xv[a][i] + mv * acc[a][b][i]);
      }
      __builtin_amdgcn_sched_barrier(0);
    }
  }
}

template <int MT, int EPI>
DI void gemm_phase(const Params& p, const u16* A, int lda, const u16* Bt, int K, int ntn, char* smem,
                           int l, int modidx, bool from_input, bool skip_ctx) {
  constexpr int BM = 64 * MT;
  constexpr int TPB = NP / BM;
  constexpr int CPB = CL / BM;
  const int ntm = skip_ctx ? NB * (TPB - CPB) : NB * TPB;
  if (blockIdx.x >= (gridDim.x >> 1)) __builtin_amdgcn_s_sleep(48);
  const int xcd = blockIdx.x & 7, jb = blockIdx.x >> 3, nbx = gridDim.x >> 3;
  const int msplit = (EPI == 1) ? 8 : 2, nsplit = 8 / msplit;
  const int mi = xcd / nsplit, ni = xcd % nsplit;
  const int mpx = ntm / msplit;
  const int nper = (ntn + nsplit - 1) / nsplit;
  const int nlo = ni * nper, nw = min(ntn, nlo + nper) - nlo;
  for (int t = jb; t < mpx * nw; t += nbx) {
    int mtc = mi * mpx + t / nw, nt = nlo + t % nw;
    int mt = skip_ctx ? (mtc / (TPB - CPB)) * TPB + CPB + (mtc % (TPB - CPB)) : mtc;
    int m0 = mt * BM;
    if (EPI == 0 && l == 1 && (m0 % NP) < CL && nt < 8) continue;
    gemm_tile<MT, EPI>(p, A, lda, Bt, K, m0, nt * 128, smem, l, modidx, from_input);
  }
}

template <int KK, int NT>
DI void small_gemm(const u16* As, int lda, const u16* __restrict__ Bt, int ldb, int n0, f32x16* acc) {
  const int lane = lane_id_(), r = lane & 31, h = lane >> 5;
#pragma unroll
  for (int t = 0; t < NT; ++t)
#pragma unroll
    for (int i = 0; i < 16; ++i) acc[t][i] = 0.f;
  const u16* bp = Bt + (size_t)(n0 + r) * ldb + h * 8;
  const u16* ap = As + r * lda + h * 8;
#pragma unroll
  for (int s0 = 0; s0 < KK / 16; s0 += 4) {
    bf16x8 a[4], b[4][NT];
#pragma unroll
    for (int s = 0; s < 4; ++s) {
      a[s] = *(const bf16x8*)(ap + (s0 + s) * 16);
#pragma unroll
      for (int t = 0; t < NT; ++t) b[s][t] = *(const bf16x8*)(bp + (size_t)(t * 32) * ldb + (s0 + s) * 16);
    }
#pragma unroll
    for (int s = 0; s < 4; ++s)
#pragma unroll
      for (int t = 0; t < NT; ++t) acc[t] = MFMA(a[s], b[s][t], acc[t]);
    __builtin_amdgcn_sched_barrier(0);
  }
}

struct TileInfo { int g0, b, pos0, lo, hi; };
DI TileInfo tile_info(int tile) {
  TileInfo t;
  t.g0 = tile * 32; t.b = t.g0 / NP; t.pos0 = t.g0 - t.b * NP;
  if (t.pos0 < CL) { t.lo = 0; t.hi = CL; } else { t.lo = CL; t.hi = NP; }
  return t;
}

DI void unpack8(const u32x4& v, float* f) {
#pragma unroll
  for (int k = 0; k < 4; ++k) { f[2 * k] = bflo(v[k]); f[2 * k + 1] = bfhi(v[k]); }
}
DI u32x4 pack8(const float* f) {
  u32x4 o;
#pragma unroll
  for (int k = 0; k < 4; ++k) o[k] = pack2(f[2 * k], f[2 * k + 1]);
  return o;
}
DI u32x4 pack8t(const float* f) {
  u32x4 o;
#pragma unroll
  for (int k = 0; k < 4; ++k) o[k] = (unsigned)f2bf(f[2 * k]) | (__float_as_uint(f[2 * k + 1]) & 0xffff0000u);
  return o;
}
DI void load8f(const float* q, float* f) {
  float4 a = *(const float4*)q, b = *(const float4*)(q + 4);
  f[0] = a.x; f[1] = a.y; f[2] = a.z; f[3] = a.w; f[4] = b.x; f[5] = b.y; f[6] = b.z; f[7] = b.w;
}
DI void lds8f(const float* q, float* f) { load8f(q, f); }

template <int NT>
DI void stage_acc(u16* O, int ldo, int col0, const f32x16* acc, int r, int h, float scale) {
#pragma unroll
  for (int t = 0; t < NT; ++t)
#pragma unroll
    for (int i = 0; i < 16; ++i) O[crow(i, h) * ldo + col0 + t * 32 + r] = f2bf(acc[t][i] * scale);
}

DI void prep_conv(const Params& pp, int l, int tile, char* smem) {
  const PW p = {opaque_p(pp.ws), pp.out, pp.wave64};
  const TileInfo ti = tile_info(tile);
  const u16* P = (const u16*)(p.ws + WS_BIG + BIG_P);
  u16* Ycat = (u16*)(p.ws + WS_H);
  u16* U = (u16*)smem;
  u16* Wb = (u16*)(smem + 31744);
  u16* A = (u16*)smem;
  u16* O = (u16*)(smem + 16896);
  const int tid = opaque(TIDX), lane = tid & 63, wave = tid >> 6, r = lane & 31, h = lane >> 5;
  const int cg = tid & 31, tq = tid >> 5, c0 = cg * 8;
  __syncthreads();
  {
    const float* dw = IN(10) + (size_t)l * 31 * 256;
#pragma unroll 8
    for (int j = 0; j < 31; ++j) Wb[j * 256 + tid] = f2bf(dw[j * 256 + tid]);
  }
#pragma unroll 4
  for (int i = 0; i < 8; ++i) {
    int e = tid + 256 * i;
    if (e < 62 * 32) {
      int tt = e >> 5, g8 = e & 31;
      int pos = ti.pos0 - 15 + tt;
      bool valid = (pos >= ti.lo) && (pos < ti.hi);
      int pc = min(max(pos, ti.lo), ti.hi - 1);
      const u16* pr = P + (size_t)(ti.b * NP + pc) * PIN + g8 * 8;
      u32x4 va = *(const u32x4*)pr, vg = *(const u32x4*)(pr + 256);
      float fa[8], fg[8];
      unpack8(va, fa); unpack8(vg, fg);
#pragma unroll
      for (int k = 0; k < 8; ++k) fa[k] = valid ? fa[k] * sigm(fg[k]) : 0.f;
      *(u32x4*)(U + tt * 256 + g8 * 8) = pack8(fa);
    }
  }
  __syncthreads();
  float y[4][8];
#pragma unroll
  for (int t = 0; t < 4; ++t)
#pragma unroll
    for (int e = 0; e < 8; ++e) y[t][e] = 0.f;
  {
    float uw[4][8];
#pragma unroll
    for (int t = 0; t < 3; ++t) unpack8(*(const u32x4*)(U + (4 * tq + t) * 256 + c0), uw[t + 1]);
#pragma unroll 1
    for (int j = 0; j < 31; ++j) {
#pragma unroll
      for (int e = 0; e < 8; ++e) { uw[0][e] = uw[1][e]; uw[1][e] = uw[2][e]; uw[2][e] = uw[3][e]; }
      unpack8(*(const u32x4*)(U + (4 * tq + j + 3) * 256 + c0), uw[3]);
      float w8[8];
      unpack8(*(const u32x4*)(Wb + j * 256 + c0), w8);
#pragma unroll
      for (int t = 0; t < 4; ++t)
#pragma unroll
        for (int e = 0; e < 8; ++e) y[t][e] += uw[t][e] * w8[e];
    }
  }
  {
    float db[8], gg[8], gb[8];
    load8f(IN(11) + l * 256 + c0, db); load8f(IN(12) + l * 256 + c0, gg); load8f(IN(13) + l * 256 + c0, gb);
#pragma unroll
    for (int t = 0; t < 4; ++t) {
      float sm = 0.f;
#pragma unroll
      for (int e = 0; e < 8; ++e) { y[t][e] += db[e]; sm += y[t][e]; }
      const float mean = sum8(sm) * (1.f / 64.f);
      float sq = 0.f;
#pragma unroll
      for (int e = 0; e < 8; ++e) { y[t][e] -= mean; sq += y[t][e] * y[t][e]; }
      const float rs = rsqrtf(sum8(sq) * (1.f / 64.f) + 1e-5f);
#pragma unroll
      for (int e = 0; e < 8; ++e) { float gn = y[t][e] * rs * gg[e] + gb[e]; y[t][e] = gn * sigm(gn); }
    }
  }
  __syncthreads();
#pragma unroll
  for (int t = 0; t < 4; ++t) *(u32x4*)(A + (4 * tq + t) * 264 + c0) = pack8(y[t]);
  __syncthreads();
  f32x16 acc[2];
  small_gemm<256, 2>(A, 264, (const u16*)(p.ws + WS_WT) + WT_PW, 256, wave * 64, acc);
  stage_acc<2>(O, 264, wave * 64, acc, r, h, 1.f);
  __syncthreads();
#pragma unroll
  for (int i = 0; i < 4; ++i) {
    int e = tid + 256 * i, row = e >> 5, cc = e & 31;
    *(u32x4*)(Ycat + (size_t)(ti.g0 + row) * DM + cc * 8) = *(const u32x4*)(O + row * 264 + cc * 8);
  }
}

template <int W>
DI void pool_body(const float* u, float* d, int pos0, int lo, int hi) {
  const int vz = opaque(0);
#pragma unroll
  for (int t = 0; t < 32; ++t) {
    float s = 0.f;
#pragma unroll
    for (int j = 0; j < W; ++j) s += u[t + 8 - W / 2 + j];
    int pos = pos0 + t + vz;
    int a = max(pos - W / 2, lo), b = min(pos + W / 2, hi);
    d[t] = s / (float)(b - a) - u[t + 8];
  }
}

DI void prep_pool(const Params& pp, int l, int tile, char* smem) {
  const PW p = {opaque_p(pp.ws), pp.out, pp.wave64};
  const TileInfo ti = tile_info(tile);
  const u16* P = (const u16*)(p.ws + WS_BIG + BIG_P);
  u16* Ycat = (u16*)(p.ws + WS_H);
  u16* A = (u16*)smem;
  const int tid = opaque(TIDX), c = tid, lane = tid & 63, wave = tid >> 6, r = lane & 31, h = lane >> 5;
  float u[47];
#pragma unroll
  for (int tt = 0; tt < 47; ++tt) {
    int pos = ti.pos0 - 8 + tt;
    bool valid = (pos >= ti.lo) && (pos < ti.hi);
    int pc = min(max(pos, ti.lo), ti.hi - 1);
    float uv = bf2f(P[(size_t)(ti.b * NP + pc) * PIN + OFF_POOL + c]);
    u[tt] = valid ? uv : 0.f;
  }
  float d[32];
  if (wave == 0) pool_body<2>(u, d, ti.pos0, ti.lo, ti.hi);
  else if (wave == 1) pool_body<4>(u, d, ti.pos0, ti.lo, ti.hi);
  else if (wave == 2) pool_body<8>(u, d, ti.pos0, ti.lo, ti.hi);
  else pool_body<16>(u, d, ti.pos0, ti.lo, ti.hi);
  __syncthreads();
#pragma unroll
  for (int t = 0; t < 32; ++t) A[t * 264 + c] = f2bf(d[t]);
  __syncthreads();
  f32x16 acc[2];
  small_gemm<64, 2>(A + wave * 64, 264, (const u16*)(p.ws + WS_WT) + WT_POOL + wave * 4096, 64, 0, acc);
  u16* O = (u16*)(smem + 16896);
#pragma unroll
  for (int t = 0; t < 2; ++t) {
    int n = wave * 64 + t * 32 + r;
    float sc = IN(16)[l * 256 + n];
#pragma unroll
    for (int i = 0; i < 16; ++i) O[crow(i, h) * 264 + n] = f2bf(acc[t][i] * sc);
  }
  __syncthreads();
#pragma unroll
  for (int i = 0; i < 4; ++i) {
    int e = tid + 256 * i, row = e >> 5, cc = e & 31;
    *(u32x4*)(Ycat + (size_t)(ti.g0 + row) * DM + 512 + cc * 8) = *(const u32x4*)(O + row * 264 + cc * 8);
  }
}

DI float rope_freq(int f) { return exp2f(-(float)f * 1.6609640474436813f); }

DI void prep_q(const Params& pp, int l, int tile, char* smem) {
  const PW p = {opaque_p(pp.ws), pp.out, pp.wave64};
  const TileInfo ti = tile_info(tile);
  const u16* P = (const u16*)(p.ws + WS_BIG + BIG_P);
  u16* Q = (u16*)(p.ws + WS_BIG + BIG_Q);
  u16* A = (u16*)smem;
  const int tid = opaque(TIDX), lane = tid & 63, wave = tid >> 6, r = lane & 31, h = lane >> 5;
  {
    const int t = tid >> 3, j = tid & 7;
    const u16* src = P + (size_t)(ti.g0 + t) * PIN + OFF_Q + j * 32;
    u32x4 v[4];
    float ss = 0.f;
#pragma unroll
    for (int i = 0; i < 4; ++i) {
      v[i] = *(const u32x4*)(src + i * 8);
#pragma unroll
      for (int k = 0; k < 4; ++k) { float a = bflo(v[i][k]), b = bfhi(v[i][k]); ss += a * a + b * b; }
    }
    ss = sum8(ss);
    float rs = rsqrtf(ss * (1.f / 256.f) + 1e-6f);
    const float* qg = IN(29) + l * 256 + j * 32;
    __syncthreads();
#pragma unroll
    for (int i = 0; i < 4; ++i) {
      u32x4 o;
#pragma unroll
      for (int k = 0; k < 4; ++k) {
        float a = bflo(v[i][k]) * rs * qg[i * 8 + 2 * k], b = bfhi(v[i][k]) * rs * qg[i * 8 + 2 * k + 1];
        o[k] = pack2(a, b);
      }
      *(u32x4*)(A + t * 264 + j * 32 + i * 8) = o;
    }
  }
  __syncthreads();
  f32x16 acc[3];
  small_gemm<256, 3>(A, 264, (const u16*)(p.ws + WS_WT) + WT_WUQ, 256, wave * 96, acc);
  const float QS = 0.10206207261596577f * 1.4426950408889634f;
  u16* O = (u16*)(smem + 16896);
  stage_acc<2>(O, 392, wave * 96, acc, r, h, QS);
  const bool lat = ti.pos0 >= CL;
  const float fr = rope_freq(r & 7);
#pragma unroll
  for (int i = 0; i < 16; ++i) {
    float val = acc[2][i];
    float par = __shfl_xor(val, 8, 64);
    int tk = crow(i, h);
    float o = val;
    if (lat) {
      int n = ti.pos0 + tk - CL;
      float pa = (float)((r < 16) ? (n >> 6) : (n & 63));
      float ang = pa * fr;
      float sn = __sinf(ang), cs = __cosf(ang);
      o = (r & 8) ? (par * sn + val * cs) : (val * cs - par * sn);
    }
    O[tk * 392 + wave * 96 + 64 + r] = f2bf(o * QS);
  }
  __syncthreads();
#pragma unroll
  for (int i = 0; i < 6; ++i) {
    int e = tid + 256 * i, row = e / 48, cc = e - row * 48;
    *(u32x4*)(Q + (size_t)(ti.g0 + row) * 384 + cc * 8) = *(const u32x4*)(O + row * 392 + cc * 8);
  }
}

DI void prep_kv(const Params& pp, int l, int tile, char* smem) {
  const PW p = {opaque_p(pp.ws), pp.out, pp.wave64};
  const TileInfo ti = tile_info(tile);
  const u16* P = (const u16*)(p.ws + WS_BIG + BIG_P);
  u16* KN = (u16*)(p.ws + WS_BIG + BIG_KN);
  u16* KR = (u16*)(p.ws + WS_BIG + BIG_KR);
  u16* VT = (u16*)(p.ws + WS_BIG + BIG_VT);
  u16* A = (u16*)smem;
  const int tid = opaque(TIDX), lane = tid & 63, wave = tid >> 6, r = lane & 31, h = lane >> 5;
  const bool lat = ti.pos0 >= CL;
  {
    const int t = tid >> 3, j = tid & 7;
    const u16* src = P + (size_t)(ti.g0 + t) * PIN + OFF_KV + j * 16;
    u32x4 v[2];
    float ss = 0.f;
#pragma unroll
    for (int i = 0; i < 2; ++i) {
      v[i] = *(const u32x4*)(src + i * 8);
#pragma unroll
      for (int k = 0; k < 4; ++k) { float a = bflo(v[i][k]), b = bfhi(v[i][k]); ss += a * a + b * b; }
    }
    ss = sum8(ss);
    float rs = rsqrtf(ss * (1.f / 128.f) + 1e-6f);
    const float* kg = IN(31) + l * 128 + j * 16;
    __syncthreads();
#pragma unroll
    for (int i = 0; i < 2; ++i) {
      u32x4 o;
#pragma unroll
      for (int k = 0; k < 4; ++k) {
        float a = bflo(v[i][k]) * rs * kg[i * 8 + 2 * k], b = bfhi(v[i][k]) * rs * kg[i * 8 + 2 * k + 1];
        o[k] = pack2(a, b);
      }
      *(u32x4*)(A + t * 136 + j * 16 + i * 8) = o;
    }
  }
#pragma unroll
  for (int i = 0; i < 4; ++i) {
    int e = tid + 256 * i, t = e >> 5, dd = e & 31;
    const u16* src = P + (size_t)(ti.g0 + t) * PIN + OFF_KV + 128;
    float val = bf2f(src[dd]), par = bf2f(src[dd ^ 8]);
    float o = val;
    if (lat) {
      int n = ti.pos0 + t - CL;
      float pa = (float)((dd < 16) ? (n >> 6) : (n & 63));
      float ang = pa * rope_freq(dd & 7);
      float sn = __sinf(ang), cs = __cosf(ang);
      o = (dd & 8) ? (par * sn + val * cs) : (val * cs - par * sn);
    }
    KR[(size_t)(ti.g0 + t) * 32 + dd] = f2bf(o);
  }
  __syncthreads();
  f32x16 acc[4];
  small_gemm<128, 4>(A, 136, (const u16*)(p.ws + WS_WT) + WT_WUKV, 128, wave * 128, acc);
  u16* O = (u16*)(smem + 16896);
  stage_acc<2>(O, 264, wave * 64, acc, r, h, 1.f);
#pragma unroll
  for (int t = 0; t < 2; ++t) {
    int dv = t * 32 + r;
    u16* dst = VT + ((size_t)((ti.b * 4 + wave) * 64 + dv)) * NP + ti.pos0;
#pragma unroll
    for (int q = 0; q < 4; ++q) {
      u32x2 o;
      o[0] = pack2(acc[2 + t][4 * q], acc[2 + t][4 * q + 1]);
      o[1] = pack2(acc[2 + t][4 * q + 2], acc[2 + t][4 * q + 3]);
      *(u32x2*)(dst + 8 * q + 4 * h) = o;
    }
  }
  __syncthreads();
#pragma unroll
  for (int i = 0; i < 4; ++i) {
    int e = tid + 256 * i, row = e >> 5, cc = e & 31;
    *(u32x4*)(KN + (size_t)(ti.g0 + row) * 256 + cc * 8) = *(const u32x4*)(O + row * 264 + cc * 8);
  }
}

DI void mix4(const u16* Pcol, const TileInfo& ti, int t0, const float* mp, const float* mn, float (*z)[8]) {
  u32x4 raw[6];
#pragma unroll
  for (int i = 0; i < 6; ++i) {
    int pos = ti.pos0 + t0 - 1 + i;
    bool ok = (pos >= ti.lo) && (pos < ti.hi);
    int pc = min(max(pos, ti.lo), ti.hi - 1);
    u32x4 v = *(const u32x4*)(Pcol + (size_t)(ti.b * NP + pc) * PIN);
    if (!ok) { v[0] = 0u; v[1] = 0u; v[2] = 0u; v[3] = 0u; }
    raw[i] = v;
  }
#pragma unroll
  for (int t = 0; t < 4; ++t) {
    float fp[8], fc[8], fn[8];
    unpack8(raw[t], fp); unpack8(raw[t + 1], fc); unpack8(raw[t + 2], fn);
#pragma unroll
    for (int e = 0; e < 8; ++e) z[t][e] = fc[e] + mp[e] * (fp[e] - fc[e]) + mn[e] * (fn[e] - fc[e]);
  }
}

DI void prep_rwkv(const Params& pp, int l, int tile, char* smem) {
  const PW p = {opaque_p(pp.ws), pp.out, pp.wave64};
  const TileInfo ti = tile_info(tile);
  const u16* P = (const u16*)(p.ws + WS_BIG + BIG_P);
  u16* Ycat = (u16*)(p.ws + WS_H);
  u16* SR = (u16*)(p.ws + WS_BIG + BIG_SR);
  u16* SKK = (u16*)(p.ws + WS_BIG + BIG_SKK);
  u16* SV = (u16*)(p.ws + WS_BIG + BIG_SV);
  u16* A3 = (u16*)smem;
  float* R = (float*)(smem + 25088);
  const u16* wt = (const u16*)(p.ws + WS_WT);
  const int tid = opaque(TIDX), lane = tid & 63, wave = tid >> 6, r = lane & 31, h = lane >> 5;
  const int cg = tid & 31, tq = tid >> 5, c0 = cg * 8, t0 = tq * 4;
  const float* mup = IN(17) + l * 1152;
  const float* mun = IN(18) + l * 1152;
  __syncthreads();
#pragma unroll 2
  for (int i = 0; i < 6; ++i) {
    int e = tid + 256 * i, t = e / 48, jg = e - t * 48, j0 = jg * 8;
    int pos = ti.pos0 + t;
    const u16* pr = P + (size_t)(ti.g0 + t) * PIN + OFF_RW + 768 + j0;
    const bool hp = pos > ti.lo, hn = pos + 1 < ti.hi;
    u32x4 vc = *(const u32x4*)pr;
    u32x4 vp = *(const u32x4*)(pr + (hp ? -PIN : 0));
    u32x4 vn = *(const u32x4*)(pr + (hn ? PIN : 0));
    float fc[8], fp[8], fn[8], mp[8], mn[8], z[8];
    unpack8(vc, fc); unpack8(vp, fp); unpack8(vn, fn);
    load8f(mup + 768 + j0, mp); load8f(mun + 768 + j0, mn);
#pragma unroll
    for (int k = 0; k < 8; ++k) {
      float pv = hp ? fp[k] : 0.f, nx = hn ? fn[k] : 0.f;
      float zz = fc[k] + mp[k] * (pv - fc[k]) + mn[k] * (nx - fc[k]);
      float sg = sigm((jg < 16) ? zz : 2.f * zz);
      z[k] = (jg < 16) ? sg : ((jg < 32) ? (2.f * sg - 1.f) : zz);
    }
    *(u32x4*)(A3 + t * 392 + j0) = pack8(z);
  }
  float zk[4][8], rzk[4][8];
  {
    float mp[8], mn[8], z[4][8];
    load8f(mup + c0, mp); load8f(mun + c0, mn);
    mix4(P + OFF_RW + c0, ti, t0, mp, mn, z);
    float rkw[8];
    load8f(IN(26) + l * 256 + c0, rkw);
#pragma unroll
    for (int t = 0; t < 4; ++t) {
      *(u32x4*)(SR + (size_t)(ti.g0 + t0 + t) * 256 + c0) = pack8t(z[t]);
#pragma unroll
      for (int e = 0; e < 8; ++e) rzk[t][e] = z[t][e] * rkw[e];
    }
    load8f(mup + 512 + c0, mp); load8f(mun + 512 + c0, mn);
    mix4(P + OFF_RW + 512 + c0, ti, t0, mp, mn, z);
#pragma unroll
    for (int t = 0; t < 4; ++t) *(u32x4*)(SV + (size_t)(ti.g0 + t0 + t) * 256 + c0) = pack8(z[t]);
    load8f(mup + 256 + c0, mp); load8f(mun + 256 + c0, mn);
    mix4(P + OFF_RW + 256 + c0, ti, t0, mp, mn, zk);
    float kkw[8];
    load8f(IN(24) + l * 256 + c0, kkw);
#pragma unroll
    for (int t = 0; t < 4; ++t) {
      float kk[8], ss = 0.f;
#pragma unroll
      for (int e = 0; e < 8; ++e) { kk[e] = zk[t][e] * kkw[e]; ss += kk[e] * kk[e]; rzk[t][e] *= zk[t][e]; }
      ss = sum8(ss);
      float inv = 1.f / fmaxf(sqrtf(ss), 1e-12f);
#pragma unroll
      for (int e = 0; e < 8; ++e) kk[e] *= inv;
      *(u32x4*)(SKK + (size_t)(ti.g0 + t0 + t) * 256 + c0) = pack8t(kk);
    }
  }
  __syncthreads();
  f32x16 acc[2];
  small_gemm<128, 2>(A3, 392, wt + WT_RG2, 128, wave * 64, acc);
#pragma unroll
  for (int t = 0; t < 2; ++t)
#pragma unroll
    for (int i = 0; i < 16; ++i) R[crow(i, h) * 260 + wave * 64 + t * 32 + r] = acc[t][i];
  __syncthreads();
#pragma unroll
  for (int t = 0; t < 4; ++t) {
    float g8[8];
    lds8f(R + (t0 + t) * 260 + c0, g8);
    *(u32x4*)(Ycat + (size_t)(ti.g0 + t0 + t) * DM + 256 + c0) = pack8(g8);
  }
  __syncthreads();
  float ka[8];
  load8f(IN(25) + l * 256 + c0, ka);
#pragma unroll 1
  for (int d = 0; d < 2; ++d) {
    u16* SDEC = (u16*)(p.ws + WS_BIG + BIG_SDEC) + (size_t)d * NTOK * 256;
    u16* SKD = (u16*)(p.ws + WS_BIG + BIG_SKD) + (size_t)d * NTOK * 256;
    u16* SB = (u16*)(p.ws + WS_BIG + BIG_SB) + (size_t)d * NTOK * 256;
    float* bo = (float*)(p.ws + WS_BONUS) + (size_t)d * NTOK * 4;
    small_gemm<64, 2>(A3 + 128 + d * 64, 392, wt + WT_RW2 + d * 16384, 64, wave * 64, acc);
#pragma unroll
    for (int t = 0; t < 2; ++t)
#pragma unroll
      for (int i = 0; i < 16; ++i) R[crow(i, h) * 260 + wave * 64 + t * 32 + r] = acc[t][i];
    __syncthreads();
    {
      float w0[8];
      load8f(IN(19) + l * 512 + d * 256 + c0, w0);
#pragma unroll
      for (int t = 0; t < 4; ++t) {
        float x8[8];
        lds8f(R + (t0 + t) * 260 + c0, x8);
#pragma unroll
        for (int e = 0; e < 8; ++e) {
          float ee = sigm(w0[e] + x8[e]) * 0.6065306597126334f;
          x8[e] = 1.f - __expf(-ee);
        }
        *(u32x4*)(SDEC + (size_t)(ti.g0 + t0 + t) * 256 + c0) = pack8t(x8);
      }
    }
    __syncthreads();
    small_gemm<64, 2>(A3 + 256 + d * 64, 392, wt + WT_RA2 + d * 16384, 64, wave * 64, acc);
#pragma unroll
    for (int t = 0; t < 2; ++t)
#pragma unroll
      for (int i = 0; i < 16; ++i) R[crow(i, h) * 260 + wave * 64 + t * 32 + r] = acc[t][i];
    __syncthreads();
    {
      float a0[8];
      load8f(IN(21) + l * 512 + d * 256 + c0, a0);
      u32x4 kraw[4];
#pragma unroll
      for (int t = 0; t < 4; ++t) kraw[t] = *(const u32x4*)(SKK + (size_t)(ti.g0 + t0 + t) * 256 + c0);
#pragma unroll
      for (int t = 0; t < 4; ++t) {
        float x8[8], kn[8], kd[8], bb[8], part = 0.f;
        lds8f(R + (t0 + t) * 260 + c0, x8);
        unpack8(kraw[t], kn);
#pragma unroll
        for (int e = 0; e < 8; ++e) {
          float a = sigm(a0[e] + x8[e]);
          float kf = 1.f + (a - 1.f) * ka[e];
          kd[e] = zk[t][e] * kf;
          bb[e] = kn[e] * a;
          part += rzk[t][e] * kf;
        }
        size_t o = (size_t)(ti.g0 + t0 + t) * 256 + c0;
        *(u32x4*)(SKD + o) = pack8t(kd);
        *(u32x4*)(SB + o) = pack8t(bb);
        part = sum8(part);
        if ((cg & 7) == 0) bo[(size_t)(ti.g0 + t0 + t) * 4 + (cg >> 3)] = part;
      }
    }
    __syncthreads();
  }
}

DI void prep_phase(const Params& p, int l, char* smem) {
  const int NT = NTOK / 32;
  for (int item = blockIdx.x; item < 3 * NT; item += gridDim.x) {
    int task = item / NT, tile = item - task * NT;
    bool ctx = (tile % 72) < 8;
    if (l == 1 && ctx && task == 1) continue;
    if (task == 0) prep_rwkv(p, l, tile, smem);
    else if (task == 1) prep_q(p, l, tile, smem);
    else prep_kv(p, l, tile, smem);
  }
}

DI void scan_item(const Params& pp, int item, char* smem) {
  const PW p = {opaque_p(pp.ws), pp.out, pp.wave64};
  const int rh = item & 1, d = (item >> 1) & 1, hd = (item >> 2) & 3, b = item >> 4;
  const int tid = opaque(TIDX), rowl = tid >> 3, ks = tid & 7;
  const u16* arr[5];
  arr[0] = (const u16*)(p.ws + WS_BIG + BIG_SR);
  arr[1] = (const u16*)(p.ws + WS_BIG + BIG_SKK);
  arr[2] = (const u16*)(p.ws + WS_BIG + BIG_SDEC) + (size_t)d * NTOK * 256;
  arr[3] = (const u16*)(p.ws + WS_BIG + BIG_SKD) + (size_t)d * NTOK * 256;
  arr[4] = (const u16*)(p.ws + WS_BIG + BIG_SB) + (size_t)d * NTOK * 256;
  const u16* SV = (const u16*)(p.ws + WS_BIG + BIG_SV);
  constexpr int CH = 32, BUFB = CH * 640 + CH * 64;
  int sj[5], soff[5];
  const u16* sbase[5];
#pragma unroll
  for (int i = 0; i < 5; ++i) {
    int e = tid + 256 * i, j = e / 40, rem = e - j * 40, a = rem >> 3, part = rem & 7;
    sj[i] = j; soff[i] = j * 640 + a * 128 + part * 16;
    sbase[i] = (a == 0 ? arr[0] : a == 1 ? arr[1] : a == 2 ? arr[2] : a == 3 ? arr[3] : arr[4]) + hd * 64 + part * 8;
  }
  const int vj = (tid >> 2) & 31, vpart = tid & 3;
  const u16* vbase = SV + hd * 64 + rh * 32 + vpart * 8;
  const int voff = CH * 640 + vj * 64 + vpart * 16;
  u32x4 rg[6];
  auto pos_of = [&](int s) -> int { return d == 0 ? s : (s < CL ? (CL - 1 - s) : (NP + CL - 1 - s)); };
  auto gload = [&](int cidx) {
#pragma unroll
    for (int i = 0; i < 5; ++i) {
      size_t g = (size_t)b * NP + pos_of(cidx * CH + sj[i]);
      rg[i] = *(const u32x4*)(sbase[i] + g * 256);
    }
    if (tid < 128) {
      size_t g = (size_t)b * NP + pos_of(cidx * CH + vj);
      rg[5] = *(const u32x4*)(vbase + g * 256);
    }
  };
  auto lstore = [&](int bufi) {
    char* bp = smem + bufi * BUFB;
#pragma unroll
    for (int i = 0; i < 5; ++i) *(u32x4*)(bp + soff[i]) = rg[i];
    if (tid < 128) *(u32x4*)(bp + voff) = rg[5];
  };
  f2 S[4];
#pragma unroll
  for (int j = 0; j < 4; ++j) S[j] = (f2){0.f, 0.f};
  constexpr int NCH = NP / CH;
  float* Yb = (float*)(smem + 2 * BUFB);
  const int wj = tid >> 3, wp = tid & 7;
  __syncthreads();
  gload(0);
  lstore(0);
  gload(1);
  __syncthreads();
  for (int cidx = 0; cidx < NCH; ++cidx) {
    if (cidx + 1 < NCH) lstore((cidx + 1) & 1);
    if (cidx + 2 < NCH) gload(cidx + 2);
    if (cidx > 0) {
      u32x4 yv = *(const u32x4*)(Yb + ((cidx - 1) & 1) * CH * 32 + wj * 32 + wp * 4);
      size_t g = (size_t)b * NP + pos_of((cidx - 1) * CH + wj);
      *(u32x4*)(yrow(p.ws, g, d) + hd * 64 + rh * 32 + wp * 4) = yv;
    }
    const char* bp = smem + (cidx & 1) * BUFB;
    float* yb = Yb + (cidx & 1) * CH * 32;
#pragma unroll 4
    for (int j = 0; j < CH; ++j) {
      const char* sp = bp + j * 640 + ks * 16;
      u32x4 r8 = *(const u32x4*)(sp);
      u32x4 k8 = *(const u32x4*)(sp + 128);
      u32x4 d8 = *(const u32x4*)(sp + 256);
      u32x4 kd8 = *(const u32x4*)(sp + 384);
      u32x4 b8 = *(const u32x4*)(sp + 512);
      float vv = bf2f(*(const u16*)(bp + CH * 640 + j * 64 + rowl * 2));
      f2 K2[4], R2[4], D2[4], KD2[4], B2[4];
#define UNPK(dst, src)                                                                   \
      dst[0] = __builtin_bit_cast(f2, __builtin_shufflevector(src, src, 0, 1));           \
      dst[1] = __builtin_bit_cast(f2, __builtin_shufflevector(src, src, 2, 3));           \
      dst[2] = (f2){bflo(src[0]), bflo(src[1])};                                          \
      dst[3] = (f2){bflo(src[2]), bflo(src[3])};
      UNPK(K2, k8) UNPK(R2, r8) UNPK(D2, d8) UNPK(KD2, kd8) UNPK(B2, b8)
#undef UNPK
      f2 sa2 = S[0] * K2[0];
      f2 sb2 = S[1] * K2[1];
      sa2 = S[2] * K2[2] + sa2;
      sb2 = S[3] * K2[3] + sb2;
      sa2 = sa2 + sb2;
      const float sa = sum8(sa2.x + sa2.y);
      const f2 vv2 = (f2){vv, vv}, san = (f2){-sa, -sa};
      f2 y2 = (f2){0.f, 0.f}, y3 = (f2){0.f, 0.f};
#pragma unroll
      for (int q = 0; q < 4; ++q) {
        f2 t = vv2 * KD2[q];
        t = san * B2[q] + t;
        f2 sn = S[q] - S[q] * D2[q];
        sn = sn + t;
        S[q] = sn;
        if (q & 1) y3 = sn * R2[q] + y3; else y2 = sn * R2[q] + y2;
      }
      y2 = y2 + y3;
      const float y = sum8(y2.x + y2.y);
      if (ks == 0) yb[j * 32 + rowl] = y;
    }
    __syncthreads();
  }
  {
    u32x4 yv = *(const u32x4*)(Yb + ((NCH - 1) & 1) * CH * 32 + wj * 32 + wp * 4);
    size_t g = (size_t)b * NP + pos_of((NCH - 1) * CH + wj);
    *(u32x4*)(yrow(p.ws, g, d) + hd * 64 + rh * 32 + wp * 4) = yv;
  }
}

DI void attn_item(const Params& pp, int item, char* smem) {
  const PW p = {opaque_p(pp.ws), pp.out, pp.wave64};
  int b, hd, q0, nkt;
  if (item < 1024) { b = item >> 6; hd = (item >> 4) & 3; q0 = CL + (item & 15) * 128; nkt = NP / 64; }
  else { int x = item - 1024; b = x >> 3; hd = (x >> 1) & 3; q0 = (x & 1) * 128; nkt = CL / 64; }
  const u16* Q = (const u16*)(p.ws + WS_BIG + BIG_Q);
  const u16* KN = (const u16*)(p.ws + WS_BIG + BIG_KN);
  const u16* KR = (const u16*)(p.ws + WS_BIG + BIG_KR);
  const u16* VT = (const u16*)(p.ws + WS_BIG + BIG_VT);
  u16* Ycat = (u16*)(p.ws + WS_H);
  u16* Ks = (u16*)smem;
  u16* Vs = Ks + 64 * 104;
  const int tid = opaque(TIDX), lane = tid & 63, wave = tid >> 6, r = lane & 31, h = lane >> 5;
  const size_t gq = (size_t)b * NP + q0 + wave * 32 + r;
  bf16x8 qf[6];
#pragma unroll
  for (int s = 0; s < 6; ++s) qf[s] = *(const bf16x8*)(Q + gq * 384 + hd * 96 + s * 16 + h * 8);
  f32x16 oacc[2];
#pragma unroll
  for (int t = 0; t < 2; ++t)
#pragma unroll
    for (int i = 0; i < 16; ++i) oacc[t][i] = 0.f;
  float m = -1e30f, lsum = 0.f;
  u32x4 rk[3], rv[2];
  auto gload = [&](int kt) {
    const size_t gk0 = (size_t)b * NP + kt * 64;
#pragma unroll
    for (int i = 0; i < 3; ++i) {
      int e = tid + 256 * i, key = e / 12, part = e - key * 12;
      const u16* src = (part < 8) ? (KN + (gk0 + key) * 256 + hd * 64 + part * 8) : (KR + (gk0 + key) * 32 + (part - 8) * 8);
      rk[i] = *(const u32x4*)src;
    }
#pragma unroll
    for (int i = 0; i < 2; ++i) {
      int e = tid + 256 * i, dv = e >> 3, part = e & 7;
      rv[i] = *(const u32x4*)(VT + ((size_t)((b * 4 + hd) * 64 + dv)) * NP + kt * 64 + part * 8);
    }
  };
  gload(0);
  for (int kt = 0; kt < nkt; ++kt) {
    __syncthreads();
#pragma unroll
    for (int i = 0; i < 3; ++i) {
      int e = tid + 256 * i, key = e / 12, part = e - key * 12;
      *(u32x4*)(Ks + key * 104 + part * 8) = rk[i];
    }
#pragma unroll
    for (int i = 0; i < 2; ++i) {
      int e = tid + 256 * i, dv = e >> 3, part = e & 7;
      *(u32x4*)(Vs + dv * 72 + part * 8) = rv[i];
    }
    __syncthreads();
    if (kt + 1 < nkt) gload(kt + 1);
    f32x16 sacc[2];
#pragma unroll
    for (int t = 0; t < 2; ++t) {
#pragma unroll
      for (int i = 0; i < 16; ++i) sacc[t][i] = 0.f;
#pragma unroll
      for (int s = 0; s < 6; ++s) {
        bf16x8 kf = *(const bf16x8*)(Ks + (t * 32 + r) * 104 + s * 16 + h * 8);
        sacc[t] = MFMA(kf, qf[s], sacc[t]);
      }
    }
    float mloc = sacc[0][0];
#pragma unroll
    for (int i = 1; i < 16; ++i) mloc = fmaxf(mloc, sacc[0][i]);
#pragma unroll
    for (int i = 0; i < 16; ++i) mloc = fmaxf(mloc, sacc[1][i]);
    mloc = fmaxf(mloc, __shfl_xor(mloc, 32, 64));
    float mnew = fmaxf(m, mloc);
    float alpha = __builtin_amdgcn_exp2f(m - mnew);
    m = mnew;
    float ls = 0.f;
#pragma unroll
    for (int t = 0; t < 2; ++t)
#pragma unroll
      for (int i = 0; i < 16; ++i) { float e = __builtin_amdgcn_exp2f(sacc[t][i] - mnew); sacc[t][i] = e; ls += e; }
    lsum = lsum * alpha + ls;
#pragma unroll
    for (int t = 0; t < 2; ++t)
#pragma unroll
      for (int i = 0; i < 16; ++i) oacc[t][i] *= alpha;
#pragma unroll
    for (int s4 = 0; s4 < 4; ++s4) {
      const int t2 = s4 >> 1, ss = s4 & 1;
      u32x4 pk;
#pragma unroll
      for (int q = 0; q < 4; ++q) pk[q] = pack2(sacc[t2][8 * ss + 2 * q], sacc[t2][8 * ss + 2 * q + 1]);
      bf16x8 pf = __builtin_bit_cast(bf16x8, pk);
#pragma unroll
      for (int dt = 0; dt < 2; ++dt) {
        const u16* vp = Vs + (dt * 32 + r) * 72 + t2 * 32 + 16 * ss + 4 * h;
        u32x2 lo = *(const u32x2*)(vp);
        u32x2 hi = *(const u32x2*)(vp + 8);
        u32x4 vv; vv[0] = lo[0]; vv[1] = lo[1]; vv[2] = hi[0]; vv[3] = hi[1];
        oacc[dt] = MFMA(__builtin_bit_cast(bf16x8, vv), pf, oacc[dt]);
      }
    }
  }
  lsum += __shfl_xor(lsum, 32, 64);
  const float inv = 1.f / lsum;
#pragma unroll
  for (int dt = 0; dt < 2; ++dt)
#pragma unroll
    for (int q = 0; q < 4; ++q) {
      u32x2 o;
      o[0] = pack2(oacc[dt][4 * q] * inv, oacc[dt][4 * q + 1] * inv);
      o[1] = pack2(oacc[dt][4 * q + 2] * inv, oacc[dt][4 * q + 3] * inv);
      *(u32x2*)(Ycat + gq * DM + 768 + hd * 64 + dt * 32 + 8 * q + 4 * h) = o;
    }
}

DI void scan_attn_phase(const Params& p, int l, char* smem) {
  for (int rep = 0; rep < opaque_s(PROBE == 2 ? 2 : 1); ++rep)
    for (int item = blockIdx.x; item < 256; item += gridDim.x) scan_item(p, item, smem);
  const int nattn = (l == 0) ? 1024 + 128 : 1024;
  const int NT = NTOK / 32;
  const int nitems = nattn + 2 * NT;
  unsigned* cnt = (unsigned*)(p.ws + WS_CNT) + l;
  int* sh = (int*)(smem + SMEM_BYTES - 16);
  while (true) {
    __syncthreads();
    if (TIDX == 0) *sh = (int)atomicAdd(cnt, 1u);
    __syncthreads();
    int item = *sh;
    if (item >= nitems) break;
    if (item < nattn) { attn_item(p, item, smem); continue; }
    int x = item - nattn;
    int task = x / NT, tile = x - task * NT;
    if (l == 1 && (tile % 72) < 8) continue;
    if (task == 0) prep_conv(p, l, tile, smem);
    else prep_pool(p, l, tile, smem);
  }
}

DI void rwkv_post_phase(const Params& p, int l) {
  const int lane = TIDX & 63, wave = TIDX >> 6;
  const int gwv = blockIdx.x * 4 + wave, nw = gridDim.x * 4;
  const u16* SV = (const u16*)(p.ws + WS_BIG + BIG_SV);
  const float* BONUS = (const float*)(p.ws + WS_BONUS);
  u16* Ycat = (u16*)(p.ws + WS_H);
  const int first = (l == 1) ? CL : 0, per_b = NP - first;
  const int total = NB * per_b * 4;
  for (int base = gwv * 4; base < total; base += nw * 4) {
    float y[4], bn[4], sv[4], gt[4];
    int gi[4], ci[4];
#pragma unroll
    for (int k = 0; k < 4; ++k) {
      int idx = base + k;
      int tk = idx >> 2, hd = idx & 3;
      int b = tk / per_b, pos = first + (tk - b * per_b);
      int g = b * NP + pos, c = hd * 64 + lane;
      gi[k] = g; ci[k] = c;
      y[k] = yrow(p.ws, (size_t)g, 0)[c] + yrow(p.ws, (size_t)g, 1)[c];
      bn[k] = BONUS[(size_t)g * 4 + hd] + BONUS[(size_t)NTOK * 4 + (size_t)g * 4 + hd];
      sv[k] = bf2f(SV[(size_t)g * 256 + c]);
      gt[k] = bf2f(Ycat[(size_t)g * DM + 256 + c]);
    }
#pragma unroll
    for (int k = 0; k < 4; ++k) {
      float mean = wsum(y[k]) * (1.f / 64.f);
      float d = y[k] - mean;
      float var = wsum(d * d) * (1.f / 64.f);
      float o = d * rsqrtf(var + 64e-5f) * IN(27)[l * 256 + ci[k]] + IN(28)[l * 256 + ci[k]];
      o = (o + bn[k] * sv[k]) * gt[k];
      Ycat[(size_t)gi[k] * DM + 256 + ci[k]] = f2bf(o);
    }
  }
}

#define XB_TMO      128
#define XB_XCNT(j)  (256  + 64 * (j))
#define XB_XSUB(j)  (1280 + 64 * (j))
#define XB_XGEN(j)  (2304 + 64 * (j))
#define XB_TOP      3328
#define XB_TOPGEN   3392
#define XCD_BAR_WORDS 3456
#define XB_SPIN_CAP (1u << 18)
#define LAS __attribute__((address_space(3)))
DI unsigned xb_ld(unsigned* p)              { return __hip_atomic_load(p, __ATOMIC_RELAXED, __HIP_MEMORY_SCOPE_AGENT); }
DI unsigned xb_add(unsigned* p, unsigned v) { return __hip_atomic_fetch_add(p, v, __ATOMIC_RELAXED, __HIP_MEMORY_SCOPE_AGENT); }
DI unsigned xb_xcc_id() { return (unsigned)__builtin_amdgcn_s_getreg((3 << 11) | 20) & 0xFu; }
#define XB_SPIN(cond, bar) do { unsigned _sp = 0; while (cond) { __builtin_amdgcn_s_sleep(1); \
    if ((++_sp & 255u) == 0u) { if (xb_ld(&(bar)[XB_TMO])) break; if (_sp > XB_SPIN_CAP) { atomicAdd(&(bar)[XB_TMO], 1u); break; } } } } while (0)
struct XcdBarrier { unsigned* bar; unsigned x; volatile LAS unsigned* st; int tid; };
DI XcdBarrier xcd_barrier_post(unsigned* bar, volatile LAS unsigned* st, int tid) {
  XcdBarrier b; b.bar = bar; b.x = xb_xcc_id(); b.st = st; b.tid = tid;
  if (tid == 0) (void)xb_add(&bar[XB_XCNT(b.x)], 1u);
  return b;
}
DI void xcd_barrier_complete(unsigned* bar, unsigned x, unsigned& nloc, unsigned& nx) {
  const unsigned G = gridDim.x * gridDim.y * gridDim.z;
  unsigned sum, cnt, mine, sp = 0u;
  for (;;) {
    sum = 0u; cnt = 0u; mine = 0u;
#pragma unroll
    for (unsigned j = 0; j < 16; ++j) { const unsigned c = xb_ld(&bar[XB_XCNT(j)]); sum += c; cnt += (c > 0u) ? 1u : 0u; mine = (j == x) ? c : mine; }
    if (sum == G) break;
    __builtin_amdgcn_s_sleep(1);
    if ((++sp & 255u) == 0u) { if (xb_ld(&bar[XB_TMO])) break; if (sp > XB_SPIN_CAP) { atomicAdd(&bar[XB_TMO], 1u); break; } }
  }
  nloc = mine > 0u ? mine : 1u; nx = cnt > 0u ? cnt : 1u;
}
DI void xcd_barrier(const XcdBarrier& b) {
  asm volatile("s_waitcnt vmcnt(0)" ::: "memory");
  __syncthreads();
  if (b.tid == 0) {
    unsigned* bar = b.bar;
    __builtin_amdgcn_s_waitcnt(0);
    unsigned nloc = b.st[0], nx = b.st[1];
    if (nloc == 0u) { xcd_barrier_complete(bar, b.x, nloc, nx); b.st[0] = nloc; b.st[1] = nx; }
    const unsigned old = xb_add(&bar[XB_XSUB(b.x)], 1u);
    const unsigned gen = old / nloc;
    if (old + 1u == (gen + 1u) * nloc) {
      __builtin_amdgcn_fence(__ATOMIC_RELEASE, "agent");
      asm volatile("s_waitcnt vmcnt(0)" ::: "memory");
      const unsigned og = xb_add(&bar[XB_TOP], 1u);
      const unsigned tg = og / nx;
      if (og + 1u == (tg + 1u) * nx) xb_add(&bar[XB_TOPGEN], 1u);
      else XB_SPIN(xb_ld(&bar[XB_TOPGEN]) == tg, bar);
      __builtin_amdgcn_fence(__ATOMIC_ACQUIRE, "agent");
      xb_add(&bar[XB_XGEN(b.x)], 1u);
      asm volatile("s_waitcnt vmcnt(0)" ::: "memory");
    } else {
      XB_SPIN(xb_ld(&bar[XB_XGEN(b.x)]) == gen, bar);
      __builtin_amdgcn_fence(__ATOMIC_ACQUIRE, "agent");
      asm volatile("s_waitcnt vmcnt(0)" ::: "memory");
    }
  }
  __syncthreads();
}

DI void write_table(const Params& p) {
  const float** tab = (const float**)(p.ws + WS_TAB);
#define TB(i) tab[i] = p.in[i];
  TB(0) TB(1) TB(2) TB(3) TB(4) TB(5) TB(6) TB(7) TB(8) TB(9) TB(10) TB(11) TB(12) TB(13) TB(14) TB(15) TB(16) TB(17)
  TB(18) TB(19) TB(20) TB(21) TB(22) TB(23) TB(24) TB(25) TB(26) TB(27) TB(28) TB(29) TB(30) TB(31) TB(32) TB(33) TB(34) TB(35)
#undef TB
}

#define PHASE(k, ...) { if (ph_lo <= (k) && (k) < ph_hi) { if ((k) > ph_lo) { xcd_barrier(xb); } for (int rep_ = 0; rep_ < opaque_s((PROBE - 100 == (k)) ? 2 : 1); ++rep_) { __VA_ARGS__; } } }
template <int L>
DI void layer_phases(const Params& p, cg::grid_group& grid, const XcdBarrier& xb, char* smem, int ph_lo, int ph_hi) {
  const u16* wt = (const u16*)(p.ws + WS_WT);
  const u16* H = (const u16*)(p.ws + WS_H);
  constexpr bool last = (L == 1);
  constexpr int base = 1 + 9 * L;
  PHASE(base + 0, {
    if (L == 1) for (int item = blockIdx.x; item < N_CONV_TILES; item += gridDim.x) convert_item<false>(p, 1, item, smem);
    norm_phase(p, L, IN(6) + L * 1024, 0, 1, L == 0, false);
  })
  PHASE(base + 1, (gemm_phase<4, 0>(p, H, DM, wt + WT_WIN, 1024, PINP / 128, smem, L, 0, false, false)))
  PHASE(base + 2, {
    for (int rep = 0; rep < opaque_s(PROBE == 3 ? 2 : 1); ++rep) prep_phase(p, L, smem);
  })
  PHASE(base + 3, scan_attn_phase(p, L, smem))
  PHASE(base + 4, rwkv_post_phase(p, L))
  PHASE(base + 5, (gemm_phase<2, 1>(p, H, DM, wt + WT_WOUT, 1024, 8, smem, L, 2, L == 0, last)))
  PHASE(base + 6, norm_phase(p, L, IN(7) + L * 1024, 3, 4, false, last))
  PHASE(base + 7, {
    for (int rep = 0; rep < opaque_s(PROBE == 1 ? 2 : 1); ++rep) gemm_phase<4, 2>(p, H, DM, wt + WT_W1, 1024, 32, smem, L, 0, false, last);
  })
  PHASE(base + 8, (gemm_phase<2, 1>(p, (const u16*)(p.ws + WS_BIG), DFF, wt + WT_W2, 4096, 8, smem, L, 5, false, last)))
}

__global__ void __launch_bounds__(256, 2) mega(Params p_, int ph_lo, int ph_hi) {
  __shared__ __attribute__((aligned(16))) char smem[SMEM_BYTES];
  __shared__ uint4 xb_words;
  cg::grid_group grid = cg::this_grid();
  if (ph_hi > 1000) grid.sync();
  Params p = p_;
  p.wave64 = __builtin_amdgcn_readfirstlane((int)threadIdx.x) & ~63;
  const int tid_ = TIDX;
  if (tid_ == 0) xb_words = make_uint4(0u, 0u, 0u, 0u);
  __syncthreads();
  const XcdBarrier xb = xcd_barrier_post((unsigned*)(p.ws + WS_BAR), (volatile LAS unsigned*)&xb_words, tid_);
  PHASE(0, {
    if (blockIdx.x == 0 && tid_ == 0) {
      unsigned* cn = (unsigned*)(p.ws + WS_CNT);
      cn[0] = 0u; cn[1] = 0u; cn[2] = 0u; cn[3] = 0u;
      write_table(p);
    }
    for (int item = blockIdx.x; item < 192 + N_CONV_TILES; item += gridDim.x) {
      if (item < 192) mod_item(p, item, smem);
      else convert_item<true>(p, 0, item - 192, smem);
    }
  })
  layer_phases<0>(p, grid, xb, smem, ph_lo, ph_hi);
  layer_phases<1>(p, grid, xb, smem, ph_lo, ph_hi);
  PHASE(19, final_norm_phase(p))
}

extern "C" void kernel_launch(void* const* d_in, const int* in_sizes, int n_in, void* d_out, int out_size, void* d_ws,
                              size_t ws_size, hipStream_t stream) {
  if (ws_size < WS_TOTAL) { fprintf(stderr, "workspace too small: %zu < %zu\n", ws_size, (size_t)WS_TOTAL); return; }
  static int grid_blocks = 0;
  if (!grid_blocks) {
    int dev = 0, cus = 0, per_cu = 0;
    hipGetDevice(&dev);
    hipDeviceGetAttribute(&cus, hipDeviceAttributeMultiprocessorCount, dev);
    hipOccupancyMaxActiveBlocksPerMultiprocessor(&per_cu, mega, 256, 0);
    if (per_cu > 2) per_cu = 2;
    if (per_cu < 1) per_cu = 1;
    grid_blocks = cus * per_cu;
  }
  Params p{};
  for (int i = 0; i < 36; ++i) p.in[i] = (const float*)d_in[i];
  p.out = (float*)d_out;
  p.ws = (char*)d_ws;
  p.wave64 = 0;
  p.pad_ = 0;
  hipMemsetAsync((char*)d_ws + WS_BAR, 0, XCD_BAR_WORDS * 4, stream);
  int lo = 0, hi = 20;
  void* args[] = {&p, &lo, &hi};
  hipError_t e = hipLaunchCooperativeKernel((void*)mega, dim3(grid_blocks), dim3(256), args, 0, stream);
  if (e != hipSuccess) fprintf(stderr, "cooperative launch failed: %s (grid %d)\n", hipGetErrorString(e), grid_blocks);
}
```
